# Optimizing an MI355X kernel written in HIP

```python
import math
import jax, jax.numpy as jnp
from jax import lax
import numpy as np

D_MODEL = 2048
BATCH = 4
SEQ = 4096
DEPTH = 2

PLE_DIM = 256
BRANCH_W = 1024
N_BRANCH = 3
CONV_W = BRANCH_W
CONV_K = 3
LRU_W = BRANCH_W
LRU_HEADS = 8
LRU_HD = LRU_W // LRU_HEADS
LRU_CONV_K = 4
LRU_C = 8.0
NSA_HEADS = 16
NSA_KV_HEADS = 4
NSA_HD = 64
NSA_W = NSA_HEADS * NSA_HD
KV_W = NSA_KV_HEADS * NSA_HD
N_NSA_BRANCH = 3
CMP_BLK = 32
CMP_STRIDE = 16
CMP_HIDDEN = 128
SLC_BLK = 64
SLC_TOPN = 16
WINDOW = 512
Q_CHUNK = 64
IN_COLS = 3 * CONV_W + 2 * LRU_W + NSA_W + 6 * KV_W + N_NSA_BRANCH * NSA_HEADS + N_BRANCH * D_MODEL
N_EXPERTS = 16
N_GROUPS = 4
EXPERTS_PER_GROUP = N_EXPERTS // N_GROUPS
TOP_K = 2
D_EXPERT = 1024
MOE_BLK = 256
ALPHA = (2 * DEPTH) ** 0.25
BETA = (8 * DEPTH) ** -0.25
LN_EPS = 1e-5
NEG = -1e30
FORCE = 1e9

kernel_name = 'hybrid_conv_lru_nsa_moe_deepnorm'


def layer_norm(x, g, b):
    x32 = x.astype(jnp.float32)
    mu = x32.mean(-1, keepdims=True)
    var = jnp.square(x32 - mu).mean(-1, keepdims=True)
    y = (x32 - mu) * lax.rsqrt(var + LN_EPS) * g.astype(jnp.float32) + b.astype(jnp.float32)
    return y.astype(x.dtype)


def causal_dwconv(u, w, b):
    k, c = w.shape
    y = lax.conv_general_dilated(u, w[:, None, :].astype(u.dtype), window_strides=(1,), padding=[(k - 1, 0)],
                                 dimension_numbers=('NWC', 'WIO', 'NWC'), feature_group_count=c)
    return y + b


def short_conv_mixer(u, gate_b, gate_c, w, b):
    return gate_b * causal_dwconv(gate_c * u, w, b)


def _lin_rec(c1, c2):
    a1, b1 = c1
    a2, b2 = c2
    return a1 * a2, a2 * b1 + b2


def rg_lru_mixer(gate_in, u, conv_w, conv_b, w_a, b_a, w_x, b_x, lam):
    bsz, seq, _ = u.shape
    xc = causal_dwconv(u, conv_w, conv_b)
    xh = xc.reshape(bsz, seq, LRU_HEADS, LRU_HD)
    r = jax.nn.sigmoid(jnp.einsum('bshi,hij->bshj', xh, w_a) + b_a).reshape(bsz, seq, LRU_W)
    i = jax.nn.sigmoid(jnp.einsum('bshi,hij->bshj', xh, w_x) + b_x).reshape(bsz, seq, LRU_W)
    log_a = -LRU_C * r.astype(jnp.float32) * jax.nn.softplus(-lam.astype(jnp.float32))
    a = jnp.exp(log_a)
    b_t = jnp.sqrt(-jnp.expm1(2.0 * log_a)) * (i * xc).astype(jnp.float32)
    _, h = lax.associative_scan(_lin_rec, (a, b_t), axis=1)
    return h.astype(u.dtype) * jax.nn.gelu(gate_in)


def nsa_compress(kv, pos, w1, b1, w2, blk_idx):
    bsz = kv.shape[0]
    nc = blk_idx.shape[0]
    blocks = kv[:, blk_idx] + pos[:, None, :]
    blocks = blocks.transpose(0, 1, 3, 2, 4).reshape(bsz, nc, NSA_KV_HEADS, CMP_BLK * NSA_HD)
    return jax.nn.gelu(blocks @ w1 + b1) @ w2


def nsa_mixer(q, kc_in, vc_in, ks_in, vs_in, kw_in, vw_in, gate_logits, cmp_pos, phi_w1, phi_b1, phi_w2):
    bsz, seq = q.shape[:2]
    dt = q.dtype
    grp = NSA_HEADS // NSA_KV_HEADS
    n_cmp = (seq - CMP_BLK) // CMP_STRIDE + 1
    n_slc = seq // SLC_BLK
    top_n = min(SLC_TOPN, n_slc)
    n_chunks = seq // Q_CHUNK
    c_start = np.arange(n_cmp) * CMP_STRIDE
    blk_idx = c_start[:, None] + np.arange(CMP_BLK)[None, :]
    cmp_end = jnp.asarray(c_start + CMP_BLK - 1, jnp.int32)
    s_start = np.arange(n_slc) * SLC_BLK
    overlap = np.clip(np.minimum(c_start[:, None] + CMP_BLK, s_start[None, :] + SLC_BLK)
                      - np.maximum(c_start[:, None], s_start[None, :]), 0, None)
    cmp_to_slc = jnp.asarray(overlap / CMP_BLK, jnp.float32)
    kc = nsa_compress(kc_in, cmp_pos[0], phi_w1[0], phi_b1[0], phi_w2[0], blk_idx)
    vc = nsa_compress(vc_in, cmp_pos[1], phi_w1[1], phi_b1[1], phi_w2[1], blk_idx)
    ks_blk = ks_in.reshape(bsz, n_slc, SLC_BLK, NSA_KV_HEADS, NSA_HD).transpose(0, 3, 1, 2, 4)
    vs_blk = vs_in.reshape(bsz, n_slc, SLC_BLK, NSA_KV_HEADS, NSA_HD).transpose(0, 3, 1, 2, 4)
    kw_pad = jnp.pad(kw_in, ((0, 0), (WINDOW, 0), (0, 0), (0, 0)))
    vw_pad = jnp.pad(vw_in, ((0, 0), (WINDOW, 0), (0, 0), (0, 0)))
    slopes = jnp.asarray(2.0 ** (-8.0 * np.arange(1, NSA_HEADS + 1) / NSA_HEADS), jnp.float32).reshape(NSA_KV_HEADS, grp)
    q = q * (NSA_HD ** -0.5)
    gates = jax.nn.sigmoid(gate_logits).reshape(bsz, seq, NSA_KV_HEADS, grp, N_NSA_BRANCH)
    b_idx = jnp.arange(bsz)[:, None, None, None]
    g_idx = jnp.arange(NSA_KV_HEADS)[None, :, None, None]
    slc_j = jnp.arange(n_slc)

    def attend_chunk(c):
        start = c * Q_CHUNK
        t = start + jnp.arange(Q_CHUNK)
        qc = lax.dynamic_slice_in_dim(q, start, Q_CHUNK, axis=1).reshape(bsz, Q_CHUNK, NSA_KV_HEADS, grp, NSA_HD)
        dist = (t[:, None] - cmp_end[None, :]).astype(jnp.float32)
        ok = dist >= 0
        s = jnp.einsum('bqgrd,bngd->bgrqn', qc, kc).astype(jnp.float32) - slopes[:, :, None, None] * dist
        p_cmp = jnp.where(ok, jax.nn.softmax(jnp.where(ok, s, NEG), axis=-1), 0.0)
        o_cmp = jnp.einsum('bgrqn,bngd->bqgrd', p_cmp.astype(dt), vc)
        imp = jnp.einsum('bgrqn,nj->bgqj', p_cmp, cmp_to_slc)
        forced = (slc_j[None, :] == 0) | (slc_j[None, :] == (t // SLC_BLK)[:, None])
        causal = slc_j[None, :] * SLC_BLK <= t[:, None]
        imp = jnp.where(forced, FORCE, jnp.where(causal, imp, -FORCE))
        _, idx = lax.top_k(imp, top_n)
        kb = ks_blk[b_idx, g_idx, idx]
        vb = vs_blk[b_idx, g_idx, idx]
        kpos = idx[..., None] * SLC_BLK + jnp.arange(SLC_BLK)
        dist = (t[None, None, :, None, None] - kpos).astype(jnp.float32)[:, :, None]
        s = jnp.einsum('bqgrd,bgqnsd->bgrqns', qc, kb).astype(jnp.float32) - slopes[None, :, :, None, None, None] * dist
        s = jnp.where(dist >= 0, s, NEG).reshape(bsz, NSA_KV_HEADS, grp, Q_CHUNK, top_n * SLC_BLK)
        p_slc = jax.nn.softmax(s, axis=-1).reshape(bsz, NSA_KV_HEADS, grp, Q_CHUNK, top_n, SLC_BLK)
        o_slc = jnp.einsum('bgrqns,bgqnsd->bqgrd', p_slc.astype(dt), vb)
        kw = lax.dynamic_slice_in_dim(kw_pad, start, WINDOW + Q_CHUNK, axis=1)
        vw = lax.dynamic_slice_in_dim(vw_pad, start, WINDOW + Q_CHUNK, axis=1)
        kpos_w = start - WINDOW + jnp.arange(WINDOW + Q_CHUNK)
        dist_w = t[:, None] - kpos_w[None, :]
        ok_w = (dist_w >= 0) & (dist_w < WINDOW) & (kpos_w[None, :] >= 0)
        s = jnp.einsum('bqgrd,bkgd->bgrqk', qc, kw).astype(jnp.float32) - slopes[:, :, None, None] * dist_w.astype(jnp.float32)
        p_win = jax.nn.softmax(jnp.where(ok_w, s, NEG), axis=-1)
        o_win = jnp.einsum('bgrqk,bkgd->bqgrd', p_win.astype(dt), vw)
        g = lax.dynamic_slice_in_dim(gates, start, Q_CHUNK, axis=1)
        o = g[..., 0:1] * o_cmp + g[..., 1:2] * o_slc + g[..., 2:3] * o_win
        return o.reshape(bsz, Q_CHUNK, NSA_W)

    out = lax.map(attend_chunk, jnp.arange(n_chunks))
    return out.transpose(1, 0, 2, 3).reshape(bsz, seq, NSA_W)


def token_mixer(x, w_in, conv_a_w, conv_a_b, lru_conv_w, lru_conv_b, lru_wa, lru_ba, lru_wx, lru_bx, lru_lam,
                cmp_pos, phi_w1, phi_b1, phi_w2, w_branch, w_out):
    bsz, seq, _ = x.shape
    widths = [CONV_W] * 3 + [LRU_W] * 2 + [NSA_W] + [KV_W] * 6 + [N_NSA_BRANCH * NSA_HEADS, N_BRANCH * D_MODEL]
    points = np.cumsum(widths)[:-1].tolist()
    z = x @ w_in
    (a_in, a_b, a_c, r_gate, r_in, q, kc, vc, ks, vs, kw, vw, nsa_g, merge_g) = jnp.split(z, points, axis=-1)
    y_a = short_conv_mixer(a_in, a_b, a_c, conv_a_w, conv_a_b)
    y_b = rg_lru_mixer(r_gate, r_in, lru_conv_w, lru_conv_b, lru_wa, lru_ba, lru_wx, lru_bx, lru_lam)
    kv_heads = lambda t: t.reshape(bsz, seq, NSA_KV_HEADS, NSA_HD)
    y_c = nsa_mixer(q.reshape(bsz, seq, NSA_HEADS, NSA_HD), kv_heads(kc), kv_heads(vc), kv_heads(ks), kv_heads(vs),
                    kv_heads(kw), kv_heads(vw), nsa_g.reshape(bsz, seq, NSA_HEADS, N_NSA_BRANCH),
                    cmp_pos, phi_w1, phi_b1, phi_w2)
    gl = jax.nn.sigmoid(merge_g).reshape(bsz, seq, N_BRANCH, D_MODEL)
    merged = (gl[:, :, 0] * (y_a @ w_branch[0]) + gl[:, :, 1] * (y_b @ w_branch[1])
              + gl[:, :, 2] * (y_c @ w_branch[2]))
    return merged @ w_out


def grouped_moe(x, w_router, b_router, w_gate_up, w_down):
    bsz, seq, d = x.shape
    n_tok = bsz * seq
    n_assign = n_tok * TOP_K
    xf = x.reshape(n_tok, d)
    affinity = jax.nn.sigmoid((xf @ w_router).astype(jnp.float32))
    select = affinity + b_router.astype(jnp.float32)
    group_score = lax.top_k(select.reshape(n_tok, N_GROUPS, EXPERTS_PER_GROUP), 2)[0].sum(-1)
    best_group = jnp.argmax(group_score, axis=-1)
    in_group = (jnp.arange(N_EXPERTS) // EXPERTS_PER_GROUP)[None, :] == best_group[:, None]
    _, expert_idx = lax.top_k(jnp.where(in_group, select, NEG), TOP_K)
    gate = jnp.take_along_axis(affinity, expert_idx, axis=-1)
    gate = gate / gate.sum(-1, keepdims=True)
    e_flat = expert_idx.reshape(n_assign)
    order = jnp.argsort(e_flat)
    e_sorted = e_flat[order]
    tok_sorted = (order // TOP_K).astype(jnp.int32)
    counts = jnp.bincount(e_flat, length=N_EXPERTS)
    padded = (counts + MOE_BLK - 1) // MOE_BLK * MOE_BLK
    pad_end = jnp.cumsum(padded)
    pad_start = pad_end - padded
    raw_start = jnp.cumsum(counts) - counts
    dest = pad_start[e_sorted] + jnp.arange(n_assign) - raw_start[e_sorted]
    n_rows = n_assign + N_EXPERTS * MOE_BLK
    n_blocks = n_rows // MOE_BLK
    row_tok = jnp.zeros((n_rows,), jnp.int32).at[dest].set(tok_sorted)
    block_expert = jnp.minimum(jnp.searchsorted(pad_end, jnp.arange(n_blocks) * MOE_BLK, side='right'), N_EXPERTS - 1)

    def expert_block(b):
        xb = xf[lax.dynamic_slice_in_dim(row_tok, b * MOE_BLK, MOE_BLK)]
        e = block_expert[b]
        g, u = jnp.split(xb @ w_gate_up[e], 2, axis=-1)
        return (jax.nn.silu(g) * u) @ w_down[e]

    rows = lax.map(expert_block, jnp.arange(n_blocks)).reshape(n_rows, d)
    dest_orig = jnp.zeros((n_assign,), dest.dtype).at[order].set(dest)
    y = rows[dest_orig].reshape(n_tok, TOP_K, d)
    return jnp.einsum('tk,tkd->td', gate.astype(x.dtype), y).reshape(bsz, seq, d)


def setup_inputs(seed: int = 0) -> dict:
    key = jax.random.key(seed)
    ks = jax.random.split(key, 26)
    f32 = jnp.float32

    def nrm(k, shape, scale):
        return jax.random.normal(k, shape, f32) * scale

    u = jax.random.uniform(ks[11], (DEPTH, LRU_W), f32, 0.9, 0.999)
    a0 = u ** (1.0 / LRU_C)
    return {
        'x': nrm(ks[0], (BATCH, SEQ, D_MODEL), 1.0),
        'p': nrm(ks[1], (DEPTH, BATCH, SEQ, PLE_DIM), 1.0),
        'w_in': nrm(ks[2], (DEPTH, D_MODEL, IN_COLS), D_MODEL ** -0.5),
        'conv_a_w': nrm(ks[3], (DEPTH, CONV_K, CONV_W), 0.5),
        'conv_a_b': nrm(ks[4], (DEPTH, CONV_W), 0.02),
        'lru_conv_w': nrm(ks[5], (DEPTH, LRU_CONV_K, LRU_W), 0.5),
        'lru_conv_b': nrm(ks[6], (DEPTH, LRU_W), 0.02),
        'lru_wa': nrm(ks[7], (DEPTH, LRU_HEADS, LRU_HD, LRU_HD), LRU_HD ** -0.5),
        'lru_ba': nrm(ks[8], (DEPTH, LRU_HEADS, LRU_HD), 0.02),
        'lru_wx': nrm(ks[9], (DEPTH, LRU_HEADS, LRU_HD, LRU_HD), LRU_HD ** -0.5),
        'lru_bx': nrm(ks[10], (DEPTH, LRU_HEADS, LRU_HD), 0.02),
        'lru_lam': jnp.log(a0) - jnp.log1p(-a0),
        'cmp_pos': nrm(ks[12], (DEPTH, 2, CMP_BLK, NSA_HD), 0.02),
        'phi_w1': nrm(ks[13], (DEPTH, 2, CMP_BLK * NSA_HD, CMP_HIDDEN), (CMP_BLK * NSA_HD) ** -0.5),
        'phi_b1': nrm(ks[14], (DEPTH, 2, CMP_HIDDEN), 0.02),
        'phi_w2': nrm(ks[15], (DEPTH, 2, CMP_HIDDEN, NSA_HD), CMP_HIDDEN ** -0.5),
        'w_branch': nrm(ks[16], (DEPTH, N_BRANCH, BRANCH_W, D_MODEL), BRANCH_W ** -0.5),
        'w_out': nrm(ks[17], (DEPTH, D_MODEL, D_MODEL), BETA * D_MODEL ** -0.5),
        'ln_g': 1.0 + nrm(ks[18], (DEPTH, 2, D_MODEL), 0.02),
        'ln_b': nrm(ks[19], (DEPTH, 2, D_MODEL), 0.02),
        'w_router': nrm(ks[20], (D_MODEL, N_EXPERTS), D_MODEL ** -0.5),
        'b_router': nrm(ks[21], (N_EXPERTS,), 0.01),
        'w_gate_up': nrm(ks[22], (DEPTH, N_EXPERTS, D_MODEL, 2 * D_EXPERT), D_MODEL ** -0.5),
        'w_down': nrm(ks[23], (DEPTH, N_EXPERTS, D_EXPERT, D_MODEL), BETA * D_EXPERT ** -0.5),
        'w_ple': nrm(ks[24], (DEPTH, PLE_DIM, D_MODEL), BETA * PLE_DIM ** -0.5),
        'w_ple_gate': nrm(ks[25], (DEPTH, D_MODEL, D_MODEL), D_MODEL ** -0.5),
    }


def reference(x, p, w_in, conv_a_w, conv_a_b, lru_conv_w, lru_conv_b, lru_wa, lru_ba, lru_wx, lru_bx, lru_lam,
              cmp_pos, phi_w1, phi_b1, phi_w2, w_branch, w_out, ln_g, ln_b, w_router, b_router,
              w_gate_up, w_down, w_ple, w_ple_gate):
    for i in range(DEPTH):
        mix = token_mixer(x, w_in[i], conv_a_w[i], conv_a_b[i], lru_conv_w[i], lru_conv_b[i], lru_wa[i], lru_ba[i],
                          lru_wx[i], lru_bx[i], lru_lam[i], cmp_pos[i], phi_w1[i], phi_b1[i], phi_w2[i],
                          w_branch[i], w_out[i])
        x = layer_norm(ALPHA * x + mix, ln_g[i, 0], ln_b[i, 0])
        ffn = grouped_moe(x, w_router, b_router, w_gate_up[i], w_down[i])
        ple = jax.nn.sigmoid(x @ w_ple_gate[i]) * (p[i] @ w_ple[i])
        x = layer_norm(ALPHA * x + ffn + ple, ln_g[i, 1], ln_b[i, 1])
    return x
```

```cpp
#include <hip/hip_runtime.h>
#include <cstdio>
#include <cstdint>

#define PHON(k) ((PHMASK >> (k)) & 1u)
#ifndef NSA_NAIVE
#define NSA_NAIVE 0
#endif
#ifndef DUP_PHASE
#define DUP_PHASE -1
#endif
#ifndef CMP_NAIVE
#define CMP_NAIVE 0
#endif
#ifndef NSA_XCHK
#define NSA_XCHK 0
#endif
#ifndef MK_SPLIT
#define MK_SPLIT 0
#endif

#define GAS __attribute__((address_space(1)))
#define LAS __attribute__((address_space(3)))
typedef unsigned short bf16;
typedef short bf16x8 __attribute__((ext_vector_type(8)));
typedef float f32x4 __attribute__((ext_vector_type(4)));
typedef float f32x2 __attribute__((ext_vector_type(2)));
typedef unsigned u32x4 __attribute__((ext_vector_type(4)));
typedef unsigned u32x2 __attribute__((ext_vector_type(2)));
typedef GAS unsigned gu32;
#define RLX_AGENT __ATOMIC_RELAXED, __HIP_MEMORY_SCOPE_AGENT
#define LDS_WAIT() asm volatile("s_waitcnt lgkmcnt(0)" ::: "memory")
#define VM_WAIT() asm volatile("s_waitcnt vmcnt(0)" ::: "memory")

constexpr int BATCH = 4, SEQ = 4096, DM = 2048, DEPTH = 2, T = BATCH * SEQ;
constexpr int PLE = 256, BW = 1024, NH = 16, NG = 4, HD = 64, KVW = 256;
constexpr int NCMP = 255, NSLC = 64, TOPN = 16, WIN = 512;
constexpr int IN_COLS = 13872, NZ = 14080;
constexpr int Z_AIN = 0, Z_AB = 1024, Z_AC = 2048, Z_RG = 3072, Z_RIN = 4096, Z_Q = 5120, Z_KC = 6144, Z_VC = 6400, Z_KS = 6656, Z_VS = 6912, Z_KW = 7168, Z_VW = 7424,
              Z_NG = 7680, Z_MG = 7936;
constexpr int NE = 16, DE = 1024;
constexpr float ALPHA = 1.41421356237309515f;
constexpr float LN_EPS = 1e-5f;
constexpr int NWAVES = 8, NTHR = 512;
constexpr int HROWS = T * 2 + NE * 256;

constexpr size_t MiB = 1u << 20;
constexpr size_t WS_CTL = 0, CTL_ZERO_BYTES = 64 * 1024;
constexpr size_t WS_LIST = 1 * MiB;
constexpr size_t WS_ROUTE = 5 * MiB;
constexpr size_t WS_AGG = 6 * MiB;
constexpr size_t WS_CMP = 8 * MiB;
constexpr size_t WS_SMALL = 9 * MiB;
constexpr size_t WS_KMX = 10 * MiB;
constexpr size_t WS_W = 16 * MiB;
constexpr size_t LW_IN = 0, LW_BR = LW_IN + (size_t)NZ * DM * 2, LW_OUT = LW_BR + (size_t)3 * DM * BW * 2, LW_GU = LW_OUT + (size_t)DM * DM * 2,
                 LW_DN = LW_GU + (size_t)NE * 2048 * DM * 2, LW_PG = LW_DN + (size_t)NE * DM * DE * 2, LW_PLE = LW_PG + (size_t)DM * DM * 2,
                 LW_LRU = LW_PLE + (size_t)DM * PLE * 2, LW_PHI1 = LW_LRU + (size_t)8 * 256 * 128 * 2, LW_PHI2 = LW_PHI1 + (size_t)2 * 128 * 2048 * 2, LW_END = LW_PHI2 + (size_t)2 * 64 * 128 * 2;
constexpr size_t LW_BYTES = 278 * MiB;
static_assert(LW_END <= LW_BYTES, "layer weights");
constexpr size_t WS_XB = 576 * MiB;
constexpr size_t WS_PB = 640 * MiB;
constexpr size_t WS_Z = 656 * MiB;
constexpr size_t WS_YA = 1096 * MiB;
constexpr int YP = 3 * 1024;
constexpr size_t WS_P = 1192 * MiB;
constexpr size_t WS_LA = 1256 * MiB, WS_LB = 1288 * MiB;
constexpr size_t WS_MB = 1384 * MiB;
constexpr size_t WS_PRE = 1448 * MiB;
constexpr size_t WS_X1H = 1576 * MiB;
constexpr size_t WS_XH = 1640 * MiB;
constexpr size_t WS_X1B = 1704 * MiB;
constexpr size_t WS_H = 1768 * MiB;
constexpr size_t WS_YM = 1840 * MiB;
constexpr size_t WS_PL = 1968 * MiB;
constexpr size_t WS_END = 2032 * MiB;
static_assert(WS_W + 2 * LW_BYTES <= WS_XB && WS_Z + (size_t)T * NZ * 2 <= WS_YA && WS_H + (size_t)HROWS * DE * 2 <= WS_YM, "ws map");
constexpr int CW_TMO = 0, CW_CODE = 1, CW_BAR = 4096, CW_CNT = 8192;
static_assert((CW_CNT + DEPTH * 64) * 4 <= (int)CTL_ZERO_BYTES && (CW_BAR + 3456) * 4 <= (int)CTL_ZERO_BYTES, "control words inside the per-call memset");

constexpr int RING_OFF = 0, RING_BYTES = 131072;
constexpr int LDSX_OFF = RING_BYTES;
constexpr int LDSX_BYTES = 12288;
constexpr int MISC_OFF = LDSX_OFF + LDSX_BYTES;
constexpr int PTR_OFF = MISC_OFF + 256;
constexpr int LDS_BYTES = 147456;
static_assert(PTR_OFF + 256 <= LDS_BYTES, "lds map");

__device__ __forceinline__ unsigned f2bf(float f) { unsigned u = __builtin_bit_cast(unsigned, f); return (u + 0x7fffu + ((u >> 16) & 1u)) >> 16; }
__device__ __forceinline__ unsigned pk2(float lo, float hi) { unsigned r; asm("v_cvt_pk_bf16_f32 %0, %1, %2" : "=v"(r) : "v"(lo), "v"(hi)); return r; }
__device__ __forceinline__ float bf2f(bf16 b) { return __builtin_bit_cast(float, ((unsigned)b) << 16); }
__device__ __forceinline__ float bflo(unsigned w) { return __builtin_bit_cast(float, w << 16); }
__device__ __forceinline__ float bfhi(unsigned w) { return __builtin_bit_cast(float, w & 0xffff0000u); }
typedef _Float16 h16x2 __attribute__((ext_vector_type(2)));
__device__ __forceinline__ unsigned pkh2(float lo, float hi) { f32x2 v = {lo, hi}; h16x2 h = __builtin_convertvector(v, h16x2); return __builtin_bit_cast(unsigned, h); }
__device__ __forceinline__ float hlo(unsigned w) { const h16x2 h = __builtin_bit_cast(h16x2, w); return (float)h[0]; }
__device__ __forceinline__ float hhi(unsigned w) { const h16x2 h = __builtin_bit_cast(h16x2, w); return (float)h[1]; }
__device__ __forceinline__ u32x4 pack8h(const float (&o)[8]) { u32x4 w; w.x = pkh2(o[0], o[1]); w.y = pkh2(o[2], o[3]); w.z = pkh2(o[4], o[5]); w.w = pkh2(o[6], o[7]); return w; }
__device__ __forceinline__ void unpack8h(const u32x4 w, float (&o)[8]) { o[0] = hlo(w.x); o[1] = hhi(w.x); o[2] = hlo(w.y); o[3] = hhi(w.y); o[4] = hlo(w.z); o[5] = hhi(w.z); o[6] = hlo(w.w); o[7] = hhi(w.w); }
__device__ __forceinline__ void unpack8(const u32x4 w, float (&o)[8]) { o[0] = bflo(w.x); o[1] = bfhi(w.x); o[2] = bflo(w.y); o[3] = bfhi(w.y); o[4] = bflo(w.z); o[5] = bfhi(w.z); o[6] = bflo(w.w); o[7] = bfhi(w.w); }
__device__ __forceinline__ float sigmoidf_(float x) { return __builtin_amdgcn_rcpf(1.0f + __expf(-x)); }
__device__ __forceinline__ float gelu_tanh(float x) {
    const float u = 0.7978845608028654f * (x + 0.044715f * x * x * x);
    return x * __builtin_amdgcn_rcpf(1.0f + __builtin_amdgcn_exp2f(-2.885390081777927f * u)); }
__device__ __forceinline__ float neg_expm1f(float x) {
    const float p = x * (1.0f + x * (0.5f + x * (0.16666667f + x * (0.041666668f + x * (0.0083333338f + x * 0.0013888889f)))));
    float e = 1.0f - __expf(x); asm volatile("" : "+v"(e));
    return (x > -0.25f) ? -p : e; }
__device__ __forceinline__ float wave_sum(float v) {
#pragma unroll
    for (int o = 1; o < 64; o <<= 1) v += __shfl_xor(v, o);
    return v;
}
__device__ __forceinline__ float wave_max(float v) {
#pragma unroll
    for (int o = 1; o < 64; o <<= 1) v = fmaxf(v, __shfl_xor(v, o));
    return v;
}

namespace pg8 {
constexpr int BM = 256, BK = 64, HALF = 128, HTB = HALF * BK * 2, STAGE_BYTES = 8 * HTB, NXCD = 8, WGM = 8;
__host__ __device__ __forceinline__ int lds_byte(int r, int c) { const int st = (r >> 4) * 2 + (c >> 5), rr = r & 15, cc = c & 31, ob = rr * 64 + cc * 2; return st * 1024 + (ob ^ (((ob >> 9) & 1) << 5)); }
__host__ __device__ __forceinline__ void stage_rc(int b, int& R, int& C) { const int st = b / 1024, sb = b % 1024, swz = sb ^ (((sb >> 9) & 1) << 5); R = (st >> 1) * 16 + swz / 64; C = (st & 1) * 32 + (swz % 64) / 2; }
__host__ __device__ __forceinline__ int perm32(int rho) { const int n = rho >> 4, i = rho & 15; return 8 * (i >> 2) + 4 * n + (i & 3); }

struct Unit { int pm, pn, e, rb; };

struct StaticOrder {
    const char* A; const char* B; size_t tstepA, tstepB;
    int nM, nN, nwg, G, c, i0, n;
    __device__ __forceinline__ void init(const bf16* A_, const bf16* Bt_, int M, int N, int K, int G_, int c_) { A = (const char*)A_; B = (const char*)Bt_; tstepA = (size_t)BM * K * 2; tstepB = tstepA; nM = M / BM; nN = N / BM; nwg = nM * nN; G = G_; c = c_; i0 = 0; n = 1 << 20; }
    __device__ __forceinline__ bool next(int i, Unit& u) const {
        if (i >= n) return false;
        const long L = (long)(i + i0) * G + c; if (L >= nwg) return false;
        int wgid = (int)L; { const int q = nwg / NXCD, r = nwg % NXCD, xcd = wgid % NXCD, off = wgid / NXCD; wgid = (xcd < r ? xcd * (q + 1) : r * (q + 1) + (xcd - r) * q) + off; }
        const int nig = WGM * nN, gid = wgid / nig, fm = gid * WGM, gsz = (nM - fm) < WGM ? (nM - fm) : WGM;
        u.pm = fm + ((wgid % nig) % gsz); u.pn = (wgid % nig) / gsz; u.e = 0; u.rb = 0; return true;
    }
    __device__ __forceinline__ const char* a_base(const Unit& u) const { return A + (size_t)u.pm * tstepA; }
    __device__ __forceinline__ const char* b_base(const Unit& u) const { return B + (size_t)u.pn * tstepB; }
    __device__ __forceinline__ int gather_row(int, int) const { return 0; }
};

struct MoeOrder {
    const char* A; const char* B; size_t tstepA, tstepB, estepB;
    const LAS int* blk_start;
    const LAS int* rows;
    int nN, G, c; int bsv;
    int nfull = 1 << 20, G2 = 1, c2 = -1;
    __device__ __forceinline__ bool next(int i, Unit& u) const {
        if (i >= nfull && c2 < 0) return false;
        const int L = i < nfull ? i * G + c : nfull * G + (i - nfull) * G2 + c2; const int nb = __builtin_amdgcn_readlane(bsv, 16);
        if (L >= nb * nN) return false;
        const int rbg = L / nN; u.pn = L - rbg * nN; u.pm = rbg;
        const int e = __builtin_popcountll(__ballot(bsv <= rbg) & 0xFFFEull);
        u.e = e; u.rb = rbg - __builtin_amdgcn_readlane(bsv, e); return true;
    }
    __device__ __forceinline__ const char* a_base(const Unit& u) const { return A + (size_t)u.pm * tstepA; }
    __device__ __forceinline__ const char* b_base(const Unit& u) const { return B + (size_t)u.e * estepB + (size_t)u.pn * tstepB; }
    __device__ __forceinline__ int gather_row(int ui, int r) const { return rows[ui * 256 + r]; }
};

__device__ __forceinline__ unsigned cvt_pk_bf16(float lo, float hi) { unsigned r; asm volatile("v_cvt_pk_bf16_f32 %0, %1, %2" : "=v"(r) : "v"(lo), "v"(hi)); return r; }

struct EpiBf16 {
    static constexpr bool PERM = true; static constexpr int NST = 16;
    bf16* O; int ldc;
    __device__ __forceinline__ void operator()(const f32x4 (&acc)[2][2][4][2], const Unit& u, int wr, int wc, int fr, int fq) const {
        const int row0 = u.pm * BM + wr * 64 + fr; const int col0 = u.pn * BM + wc * 32 + 8 * fq;
#pragma unroll
        for (int ai = 0; ai < 2; ++ai)
#pragma unroll
            for (int m = 0; m < 4; ++m) { bf16* rowp = O + (size_t)(row0 + ai * HALF + m * 16) * ldc + col0;
#pragma unroll
                for (int bj = 0; bj < 2; ++bj) { const f32x4 v0 = acc[ai][bj][m][0], v1 = acc[ai][bj][m][1];
                    u32x4 w; w.x = cvt_pk_bf16(v0[0], v0[1]); w.y = cvt_pk_bf16(v0[2], v0[3]); w.z = cvt_pk_bf16(v1[0], v1[1]); w.w = cvt_pk_bf16(v1[2], v1[3]);
                    *(GAS u32x4*)(rowp + bj * HALF) = w; } }
    }
};
struct EpiZ {
    static constexpr bool PERM = true; static constexpr int NST = 16;
    bf16* O; int ldc; int sig_pn; bool skip;
    __device__ __forceinline__ void operator()(const f32x4 (&acc)[2][2][4][2], const Unit& u, int wr, int wc, int fr, int fq) const {
        if (skip) {
#pragma unroll
            for (int ai = 0; ai < 2; ++ai)
#pragma unroll
                for (int bj = 0; bj < 2; ++bj)
#pragma unroll
                    for (int m = 0; m < 4; ++m) asm volatile("" :: "v"(acc[ai][bj][m][0]), "v"(acc[ai][bj][m][1]));
            return; }
        const int row0 = u.pm * BM + wr * 64 + fr; const int col0 = u.pn * BM + wc * 32 + 8 * fq; const bool sg = u.pn >= sig_pn;
#pragma unroll
        for (int ai = 0; ai < 2; ++ai)
#pragma unroll
            for (int m = 0; m < 4; ++m) { bf16* rowp = O + (size_t)(row0 + ai * HALF + m * 16) * ldc + col0;
#pragma unroll
                for (int bj = 0; bj < 2; ++bj) { f32x4 v0 = acc[ai][bj][m][0], v1 = acc[ai][bj][m][1];
                    if (sg) {
#pragma unroll
                        for (int j = 0; j < 4; ++j) { v0[j] = 1.0f + __expf(-v0[j]); v1[j] = 1.0f + __expf(-v1[j]); } }
                    u32x4 w; w.x = cvt_pk_bf16(v0[0], v0[1]); w.y = cvt_pk_bf16(v0[2], v0[3]); w.z = cvt_pk_bf16(v1[0], v1[1]); w.w = cvt_pk_bf16(v1[2], v1[3]);
                    *(GAS u32x4*)(rowp + bj * HALF) = w; } }
    }
};
struct EpiMerge {
    static constexpr bool PERM = true; static constexpr int NST = 16;
    bf16* O; int ldc; const bf16* G; int ldg;
    __device__ __forceinline__ void rescale(f32x4 (&acc)[2][2][4][2], const Unit& u, int seg, int wr, int wc, int fr, int fq) const {
        int zero = 0; asm volatile("" : "+v"(zero));
        const int row0 = u.pm * BM + wr * 64 + fr + zero; const int col0 = u.pn * BM + wc * 32 + 8 * fq;
#pragma unroll
        for (int ai = 0; ai < 2; ++ai) {
            u32x4 ga[4][2], gb[4][2];
#pragma unroll
            for (int m = 0; m < 4; ++m) { const bf16* gp = G + (size_t)(row0 + ai * HALF + m * 16) * ldg + (seg - 1) * 2048 + col0;
#pragma unroll
                for (int bj = 0; bj < 2; ++bj) { ga[m][bj] = *(const GAS u32x4*)(gp + bj * HALF); gb[m][bj] = *(const GAS u32x4*)(gp + 2048 + bj * HALF); } }
            __builtin_amdgcn_sched_barrier(0);
#pragma unroll
            for (int m = 0; m < 4; ++m)
#pragma unroll
                for (int bj = 0; bj < 2; ++bj) { const unsigned gaw[4] = {ga[m][bj].x, ga[m][bj].y, ga[m][bj].z, ga[m][bj].w}, gbw[4] = {gb[m][bj].x, gb[m][bj].y, gb[m][bj].z, gb[m][bj].w};
#pragma unroll
                    for (int j = 0; j < 4; ++j) { const float r0 = bflo(gbw[j]) * __builtin_amdgcn_rcpf(bflo(gaw[j])), r1 = bfhi(gbw[j]) * __builtin_amdgcn_rcpf(bfhi(gaw[j]));
                        acc[ai][bj][m][j >> 1][2 * (j & 1)] *= r0; acc[ai][bj][m][j >> 1][2 * (j & 1) + 1] *= r1; } }
#pragma unroll
            for (int m = 0; m < 4; ++m) asm volatile("" : "+v"(acc[ai][0][m][0]), "+v"(acc[ai][0][m][1]), "+v"(acc[ai][1][m][0]), "+v"(acc[ai][1][m][1]));
            asm volatile("" ::: "memory"); }
    }
    __device__ __forceinline__ void operator()(const f32x4 (&acc)[2][2][4][2], const Unit& u, int wr, int wc, int fr, int fq) const {
        const int row0 = u.pm * BM + wr * 64 + fr; const int col0 = u.pn * BM + wc * 32 + 8 * fq;
        u32x4 gcv[2][4][2];
#pragma unroll
        for (int ai = 0; ai < 2; ++ai)
#pragma unroll
            for (int m = 0; m < 4; ++m) { const bf16* gp = G + (size_t)(row0 + ai * HALF + m * 16) * ldg + 2 * 2048 + col0;
#pragma unroll
                for (int bj = 0; bj < 2; ++bj) gcv[ai][m][bj] = *(const GAS u32x4*)(gp + bj * HALF); }
#pragma unroll
        for (int ai = 0; ai < 2; ++ai)
#pragma unroll
            for (int m = 0; m < 4; ++m) { const size_t r = (size_t)(row0 + ai * HALF + m * 16); bf16* rowp = O + r * ldc + col0;
#pragma unroll
                for (int bj = 0; bj < 2; ++bj) { const u32x4 gc = gcv[ai][m][bj]; const f32x4 v0 = acc[ai][bj][m][0], v1 = acc[ai][bj][m][1];
                    const float q0 = __builtin_amdgcn_rcpf(bflo(gc.x)), q1 = __builtin_amdgcn_rcpf(bfhi(gc.x)), q2 = __builtin_amdgcn_rcpf(bflo(gc.y)), q3 = __builtin_amdgcn_rcpf(bfhi(gc.y)),
                                q4 = __builtin_amdgcn_rcpf(bflo(gc.z)), q5 = __builtin_amdgcn_rcpf(bfhi(gc.z)), q6 = __builtin_amdgcn_rcpf(bflo(gc.w)), q7 = __builtin_amdgcn_rcpf(bfhi(gc.w));
                    u32x4 w; w.x = cvt_pk_bf16(v0[0] * q0, v0[1] * q1); w.y = cvt_pk_bf16(v0[2] * q2, v0[3] * q3);
                    w.z = cvt_pk_bf16(v1[0] * q4, v1[1] * q5); w.w = cvt_pk_bf16(v1[2] * q6, v1[3] * q7);
                    *(GAS u32x4*)(rowp + bj * HALF) = w; } }
    }
};
struct EpiResH {
    static constexpr bool PERM = true; static constexpr int NST = 16;
    unsigned short* O; const unsigned short* R; int ldc; float alpha;
    __device__ __forceinline__ void operator()(const f32x4 (&acc)[2][2][4][2], const Unit& u, int wr, int wc, int fr, int fq) const {
        const int row0 = u.pm * BM + wr * 64 + fr; const int col0 = u.pn * BM + wc * 32 + 8 * fq;
        u32x4 rv[2][4][2];
#pragma unroll
        for (int ai = 0; ai < 2; ++ai)
#pragma unroll
            for (int m = 0; m < 4; ++m) { const size_t off = (size_t)(row0 + ai * HALF + m * 16) * ldc + col0;
#pragma unroll
                for (int bj = 0; bj < 2; ++bj) rv[ai][m][bj] = *(const GAS u32x4*)(R + off + bj * HALF); }
#pragma unroll
        for (int ai = 0; ai < 2; ++ai)
#pragma unroll
            for (int m = 0; m < 4; ++m) { const size_t off = (size_t)(row0 + ai * HALF + m * 16) * ldc + col0;
#pragma unroll
                for (int bj = 0; bj < 2; ++bj) { const u32x4 r = rv[ai][m][bj]; const f32x4 v0 = acc[ai][bj][m][0], v1 = acc[ai][bj][m][1];
                    u32x4 w; w.x = pkh2(v0[0] + alpha * hlo(r.x), v0[1] + alpha * hhi(r.x)); w.y = pkh2(v0[2] + alpha * hlo(r.y), v0[3] + alpha * hhi(r.y));
                    w.z = pkh2(v1[0] + alpha * hlo(r.z), v1[1] + alpha * hhi(r.z)); w.w = pkh2(v1[2] + alpha * hlo(r.w), v1[3] + alpha * hhi(r.w));
                    *(GAS u32x4*)(O + off + bj * HALF) = w; } }
    }
};
struct EpiPleGate {
    static constexpr bool PERM = true; static constexpr int NST = 8;
    unsigned short* O; const unsigned short* X1; const bf16* PL; int ldc; float alpha;
    __device__ __forceinline__ void operator()(const f32x4 (&acc)[2][2][4][2], const Unit& u, int wr, int wc, int fr, int fq) const {
        const int row0 = u.pm * BM + wr * 64 + fr; const int col0 = u.pn * BM + wc * 32 + 8 * fq;
#pragma unroll
        for (int ai = 0; ai < 2; ++ai) {
            u32x4 rv[4][2], pv[4][2];
#pragma unroll
            for (int m = 0; m < 4; ++m) { const size_t off = (size_t)(row0 + ai * HALF + m * 16) * ldc + col0;
#pragma unroll
                for (int bj = 0; bj < 2; ++bj) { rv[m][bj] = *(const GAS u32x4*)(X1 + off + bj * HALF); pv[m][bj] = *(const GAS u32x4*)(PL + off + bj * HALF); } }
#pragma unroll
            for (int m = 0; m < 4; ++m) { const size_t off = (size_t)(row0 + ai * HALF + m * 16) * ldc + col0;
#pragma unroll
                for (int bj = 0; bj < 2; ++bj) { const u32x4 r = rv[m][bj], p = pv[m][bj]; const f32x4 v0 = acc[ai][bj][m][0], v1 = acc[ai][bj][m][1];
                    u32x4 w; w.x = pkh2(alpha * hlo(r.x) + sigmoidf_(v0[0]) * bflo(p.x), alpha * hhi(r.x) + sigmoidf_(v0[1]) * bfhi(p.x));
                    w.y = pkh2(alpha * hlo(r.y) + sigmoidf_(v0[2]) * bflo(p.y), alpha * hhi(r.y) + sigmoidf_(v0[3]) * bfhi(p.y));
                    w.z = pkh2(alpha * hlo(r.z) + sigmoidf_(v1[0]) * bflo(p.z), alpha * hhi(r.z) + sigmoidf_(v1[1]) * bfhi(p.z));
                    w.w = pkh2(alpha * hlo(r.w) + sigmoidf_(v1[2]) * bflo(p.w), alpha * hhi(r.w) + sigmoidf_(v1[3]) * bfhi(p.w));
                    *(GAS u32x4*)(O + off + bj * HALF) = w; } } }
    }
};
struct EpiMoeUp {
    static constexpr bool PERM = true; static constexpr int NST = 8;
    bf16* H;
    __device__ __forceinline__ void operator()(const f32x4 (&acc)[2][2][4][2], const Unit& u, int wr, int wc, int fr, int fq) const {
        const int row0 = u.pm * BM + wr * 64 + fr; const int col0 = u.pn * 128 + wc * 32 + 8 * fq;
#pragma unroll
        for (int ai = 0; ai < 2; ++ai)
#pragma unroll
            for (int m = 0; m < 4; ++m) { bf16* rowp = H + (size_t)(row0 + ai * HALF + m * 16) * DE + col0;
                float h[8];
#pragma unroll
                for (int n = 0; n < 2; ++n)
#pragma unroll
                    for (int j = 0; j < 4; ++j) { const float g = acc[ai][0][m][n][j], uu = acc[ai][1][m][n][j]; h[n * 4 + j] = g * sigmoidf_(g) * uu; }
                u32x4 w; w.x = cvt_pk_bf16(h[0], h[1]); w.y = cvt_pk_bf16(h[2], h[3]); w.z = cvt_pk_bf16(h[4], h[5]); w.w = cvt_pk_bf16(h[6], h[7]);
                *(GAS u32x4*)rowp = w; }
    }
};
struct EpiMoeDown {
    static constexpr bool PERM = true; static constexpr int NST = 0;
    bf16* YM; const int* dst; const float* gate; const LAS int* cnt;
    __device__ __forceinline__ void operator()(const f32x4 (&acc)[2][2][4][2], const Unit& u, int wr, int wc, int fr, int fq) const {
        const int pos0 = u.rb * BM + wr * 64 + fr; const int col0 = u.pn * BM + wc * 32 + 8 * fq; const int ce = cnt[u.e];
        int dd[2][4]; float gg[2][4];
#pragma unroll
        for (int ai = 0; ai < 2; ++ai)
#pragma unroll
            for (int m = 0; m < 4; ++m) { const int pos = pos0 + ai * HALF + m * 16; const size_t li = (size_t)u.e * T + (pos < ce ? pos : 0);
                dd[ai][m] = *(const GAS int*)(dst + li); gg[ai][m] = *(const GAS float*)(gate + li); }
        asm volatile("" : "+v"(dd[0][0]), "+v"(dd[0][1]), "+v"(dd[0][2]), "+v"(dd[0][3]), "+v"(dd[1][0]), "+v"(dd[1][1]), "+v"(dd[1][2]), "+v"(dd[1][3]),
                          "+v"(gg[0][0]), "+v"(gg[0][1]), "+v"(gg[0][2]), "+v"(gg[0][3]), "+v"(gg[1][0]), "+v"(gg[1][1]), "+v"(gg[1][2]), "+v"(gg[1][3]));
#pragma unroll
        for (int ai = 0; ai < 2; ++ai)
#pragma unroll
            for (int m = 0; m < 4; ++m) { const int pos = pos0 + ai * HALF + m * 16;
                if (pos < ce) { const int d = dd[ai][m]; const float gt = gg[ai][m]; bf16* rowp = YM + (size_t)d * DM + col0;
#pragma unroll
                    for (int bj = 0; bj < 2; ++bj) { const f32x4 v0 = acc[ai][bj][m][0] * gt, v1 = acc[ai][bj][m][1] * gt;
                        u32x4 w; w.x = cvt_pk_bf16(v0[0], v0[1]); w.y = cvt_pk_bf16(v0[2], v0[3]); w.z = cvt_pk_bf16(v1[0], v1[1]); w.w = cvt_pk_bf16(v1[2], v1[3]);
                        *(GAS u32x4*)(rowp + bj * HALF) = w; } } }
    }
};

template <class Epi, class Sched, bool GATHER, bool SEGHOOK = false>
__device__ __forceinline__ void gemm_phase(LAS unsigned char* lds, const int K, const Sched& S, const Epi& E, int tid_) {
    asm volatile("" : "+v"(tid_));
    const int tid = tid_, wid = __builtin_amdgcn_readfirstlane(tid >> 6), lane = tid & 63, wr = wid >> 2, wc = wid & 3, fr = lane & 15, fq = lane >> 4;
    const int nt = K / BK;
    unsigned voffA[2], voffB[2];
    unsigned oa[2][2];
    const size_t kstep = (size_t)(BK * 2);
    const size_t hstep = (size_t)HALF * K * 2;
    int Rst0, Cst0;
    { int R, C; stage_rc(tid * 16, R, C); Rst0 = R; Cst0 = C; }
#pragma unroll
    for (int i = 0; i < 2; ++i) { int R, C; stage_rc(tid * 16 + i * 8192, R, C); const int Rb = Epi::PERM ? ((R & ~31) + perm32(R & 31)) : R;
        voffA[i] = (unsigned)(R * K + C) * 2u; voffB[i] = (unsigned)(Rb * K + C) * 2u; oa[0][i] = 0u; oa[1][i] = 0u; }
#define PG8_STAGE_A(bufoff, kptr, h) do { if constexpr (GATHER) { PG8_STAGE(bufoff, kptr, oa[h]); } else { PG8_STAGE(bufoff, (kptr) + (h) * hstep, voffA); } } while (0)
#define PG8_GATHER_OFFS(uidx) do { _Pragma("unroll") for (int _h = 0; _h < 2; ++_h) _Pragma("unroll") for (int _i = 0; _i < 2; ++_i) \
        oa[_h][_i] = (unsigned)(S.gather_row((uidx), _h * HALF + _i * 64 + Rst0) * K + Cst0) * 2u; } while (0)
    const unsigned ldsw = (unsigned)wid * 1024u;
    const int aoff = lds_byte(wr * 64 + fr, fq * 8), boff = lds_byte(wc * 32 + fr, fq * 8);
#define PG8_SA(b, h) (((b) * 2 + (h)) * HTB)
#define PG8_SB(b, h) ((4 + (b) * 2 + (h)) * HTB)
#define PG8_STAGE(bufoff, gbase, voff) do { _Pragma("unroll") for (int _i = 0; _i < 2; ++_i) \
        __builtin_amdgcn_global_load_lds((const unsigned*)((const char*)(gbase) + (voff)[_i]), (LAS unsigned*)(lds + (bufoff) + ldsw + _i * 8192), 16, 0, 0); } while (0)
#define PG8_LDA(dst, b, h) do { _Pragma("unroll") for (int m = 0; m < 4; ++m) _Pragma("unroll") for (int k = 0; k < 2; ++k) dst[m][k] = *(const LAS bf16x8*)(lds + PG8_SA(b, h) + aoff + m * 2048 + k * 1024); } while (0)
#define PG8_LDB(dst, b, h) do { _Pragma("unroll") for (int n = 0; n < 2; ++n) _Pragma("unroll") for (int k = 0; k < 2; ++k) dst[n][k] = *(const LAS bf16x8*)(lds + PG8_SB(b, h) + boff + n * 2048 + k * 1024); } while (0)
#define PG8_MMA(ai, bj, At, Bt) do { __builtin_amdgcn_s_setprio(1); _Pragma("unroll") for (int m = 0; m < 4; ++m) _Pragma("unroll") for (int n = 0; n < 2; ++n) _Pragma("unroll") for (int k = 0; k < 2; ++k) \
        acc[ai][bj][m][n] = __builtin_amdgcn_mfma_f32_16x16x32_bf16(Bt[n][k], At[m][k], acc[ai][bj][m][n], 0, 0, 0); __builtin_amdgcn_s_setprio(0); } while (0)
#define PG8_WAIT_V(n) asm volatile("s_waitcnt vmcnt(" #n ")" ::: "memory")
#define PG8_WAIT_L(n) asm volatile("s_waitcnt lgkmcnt(" #n ")" ::: "memory")
#define PG8_WAIT_VF do { if constexpr (Epi::NST == 16) { if (t == 0 && ui > 0) PG8_WAIT_V(24); else PG8_WAIT_V(8); } else if constexpr (Epi::NST == 8) { if (t == 0 && ui > 0) PG8_WAIT_V(16); else PG8_WAIT_V(8); } else PG8_WAIT_V(8); } while (0)
#define PG8_BAR __builtin_amdgcn_s_barrier()
#define PG8_SCHED __builtin_amdgcn_sched_barrier(0)
    Unit cur, nxt; int ui = 0;
    if (!S.next(0, cur)) return;
    if constexpr (GATHER) { PG8_GATHER_OFFS(0); }
    f32x4 acc[2][2][4][2];
#pragma unroll
    for (int a = 0; a < 2; ++a)
#pragma unroll
        for (int b = 0; b < 2; ++b)
#pragma unroll
            for (int m = 0; m < 4; ++m)
#pragma unroll
                for (int n = 0; n < 2; ++n) acc[a][b][m][n] = (f32x4){0.f, 0.f, 0.f, 0.f};
    bf16x8 At[4][2], B0[2][2], B1[2][2];
    const char* cA = S.a_base(cur); const char* cB = S.b_base(cur);
    PG8_STAGE(PG8_SB(0, 0), cB, voffB); PG8_STAGE(PG8_SB(0, 1), cB + hstep, voffB); PG8_STAGE_A(PG8_SA(0, 0), cA, 0); PG8_STAGE_A(PG8_SA(0, 1), cA, 1);
    if (wr == 1) PG8_BAR;
    PG8_WAIT_V(2); PG8_BAR;
    PG8_STAGE(PG8_SB(1, 0), cB + kstep, voffB); PG8_STAGE_A(PG8_SA(1, 0), cA + kstep, 0); PG8_STAGE(PG8_SB(1, 1), cB + hstep + kstep, voffB);
    PG8_WAIT_V(6); PG8_BAR;
    for (;;) {
        const bool has_next = S.next(ui + 1, nxt);
        const char* nA = has_next ? S.a_base(nxt) : cA; const char* nB = has_next ? S.b_base(nxt) : cB;
#pragma unroll 1
        for (int t = 0; t < nt; t += 2) {
            const bool last = (t == nt - 2);
            if constexpr (SEGHOOK) { if (t == 16 || t == 32) E.rescale(acc, cur, t >> 4, wr, wc, fr, fq); }
            const char* a1 = cA + (size_t)(t + 1) * kstep;
            const char* a2 = last ? nA : cA + (size_t)(t + 2) * kstep; const char* b2 = last ? nB : cB + (size_t)(t + 2) * kstep;
            const char* a3 = a2 + kstep; const char* b3 = b2 + kstep;
            PG8_LDB(B0, 0, 0); PG8_LDB(B1, 0, 1); PG8_SCHED; PG8_LDA(At, 0, 0); PG8_STAGE_A(PG8_SA(1, 1), a1, 1);
            if constexpr (GATHER) { if (last && has_next) { PG8_GATHER_OFFS(ui + 1); } }
            PG8_WAIT_VF; PG8_WAIT_L(0); PG8_BAR; PG8_MMA(0, 0, At, B0); PG8_MMA(0, 1, At, B1); PG8_BAR; PG8_SCHED;
            PG8_LDA(At, 0, 1); PG8_STAGE(PG8_SB(0, 0), b2, voffB); PG8_STAGE(PG8_SB(0, 1), b2 + hstep, voffB); PG8_STAGE_A(PG8_SA(0, 0), a2, 0);
            PG8_WAIT_VF; PG8_WAIT_L(0); PG8_BAR; PG8_MMA(1, 0, At, B0); PG8_MMA(1, 1, At, B1); PG8_BAR; PG8_SCHED;
            PG8_LDB(B0, 1, 0); PG8_LDB(B1, 1, 1); PG8_SCHED; PG8_LDA(At, 1, 0); PG8_STAGE_A(PG8_SA(0, 1), a2, 1);
            PG8_WAIT_V(8); PG8_WAIT_L(0); PG8_BAR; PG8_MMA(0, 0, At, B0); PG8_MMA(0, 1, At, B1); PG8_BAR; PG8_SCHED;
            PG8_LDA(At, 1, 1); PG8_STAGE(PG8_SB(1, 0), b3, voffB); PG8_STAGE(PG8_SB(1, 1), b3 + hstep, voffB); PG8_STAGE_A(PG8_SA(1, 0), a3, 0);
            PG8_WAIT_V(8); PG8_WAIT_L(0); PG8_BAR; PG8_MMA(1, 0, At, B0); PG8_MMA(1, 1, At, B1); PG8_BAR; PG8_SCHED;
        }
        if (wr == 0) PG8_BAR;
        E(acc, cur, wr, wc, fr, fq);
        if (!has_next) break;
#pragma unroll
        for (int a = 0; a < 2; ++a)
#pragma unroll
            for (int b = 0; b < 2; ++b)
#pragma unroll
                for (int m = 0; m < 4; ++m)
#pragma unroll
                    for (int n = 0; n < 2; ++n) acc[a][b][m][n] = (f32x4){0.f, 0.f, 0.f, 0.f};
        cur = nxt; cA = nA; cB = nB; ++ui;
        if (wr == 1) PG8_BAR;
    }
    PG8_WAIT_V(0);
    PG8_BAR;
#undef PG8_SA
#undef PG8_SB
#undef PG8_STAGE
#undef PG8_STAGE_A
#undef PG8_GATHER_OFFS
#undef PG8_LDA
#undef PG8_LDB
#undef PG8_MMA
#undef PG8_WAIT_V
#undef PG8_WAIT_L
#undef PG8_BAR
#undef PG8_SCHED
}
}

#define XB_TMO      128
#define XB_XCNT(j)  (256  + 64 * (j))
#define XB_XSUB(j)  (1280 + 64 * (j))
#define XB_XGEN(j)  (2304 + 64 * (j))
#define XB_TOP      3328
#define XB_TOPGEN   3392
#define XCD_BAR_WORDS 3456
#define XB_SPIN_CAP (1u << 18)
__device__ __forceinline__ unsigned xb_ld(unsigned* p)              { return __hip_atomic_load(p, __ATOMIC_RELAXED, __HIP_MEMORY_SCOPE_AGENT); }
__device__ __forceinline__ unsigned xb_add(unsigned* p, unsigned v) { return __hip_atomic_fetch_add(p, v, __ATOMIC_RELAXED, __HIP_MEMORY_SCOPE_AGENT); }
__device__ __forceinline__ unsigned xb_xcc_id() { return (unsigned)__builtin_amdgcn_s_getreg((3 << 11) | 20) & 0xFu; }
#define XB_SPIN(cond, bar) do { unsigned _sp = 0; while (cond) { __builtin_amdgcn_s_sleep(1); \
    if ((++_sp & 255u) == 0u) { if (xb_ld(&(bar)[XB_TMO])) break; if (_sp > XB_SPIN_CAP) { atomicAdd(&(bar)[XB_TMO], 1u); break; } } } } while (0)
struct XcdBarrier { unsigned* bar; unsigned x; volatile LAS unsigned* st; };
__device__ __forceinline__ XcdBarrier xcd_barrier_post(unsigned* bar, volatile LAS unsigned* st) {
    XcdBarrier b; b.bar = bar; b.x = xb_xcc_id(); b.st = st;
    if (threadIdx.x == 0) (void)xb_add(&bar[XB_XCNT(b.x)], 1u);
    return b;
}
__device__ __forceinline__ void xcd_barrier_complete(unsigned* bar, unsigned x, unsigned& nloc, unsigned& nx) {
    const unsigned G = gridDim.x * gridDim.y * gridDim.z;
    unsigned sum, cnt, mine, sp = 0u;
    for (;;) {
        sum = 0u; cnt = 0u; mine = 0u;
#pragma unroll
        for (unsigned j = 0; j < 16; ++j) { const unsigned c = xb_ld(&bar[XB_XCNT(j)]); sum += c; cnt += (c > 0u) ? 1u : 0u; mine = (j == x) ? c : mine; }
        if (sum == G) break;
        __builtin_amdgcn_s_sleep(1);
        if ((++sp & 255u) == 0u) { if (xb_ld(&bar[XB_TMO])) break; if (sp > XB_SPIN_CAP) { atomicAdd(&bar[XB_TMO], 1u); break; } }
    }
    nloc = mine > 0u ? mine : 1u; nx = cnt > 0u ? cnt : 1u;
}
__device__ __forceinline__ void xcd_barrier(const XcdBarrier& b) {
    asm volatile("s_waitcnt vmcnt(0)" ::: "memory");
    __syncthreads();
    if (threadIdx.x == 0) {
        unsigned* bar = b.bar;
        __builtin_amdgcn_s_waitcnt(0);
        unsigned nloc = b.st[0], nx = b.st[1];
        if (nloc == 0u) { xcd_barrier_complete(bar, b.x, nloc, nx); b.st[0] = nloc; b.st[1] = nx; }
        const unsigned old = xb_add(&bar[XB_XSUB(b.x)], 1u);
        const unsigned gen = old / nloc;
        if (old + 1u == (gen + 1u) * nloc) {
            __builtin_amdgcn_fence(__ATOMIC_RELEASE, "agent");
            asm volatile("s_waitcnt vmcnt(0)" ::: "memory");
            const unsigned og = xb_add(&bar[XB_TOP], 1u);
            const unsigned tg = og / nx;
            if (og + 1u == (tg + 1u) * nx) xb_add(&bar[XB_TOPGEN], 1u);
            else XB_SPIN(xb_ld(&bar[XB_TOPGEN]) == tg, bar);
            __builtin_amdgcn_fence(__ATOMIC_ACQUIRE, "agent");
            xb_add(&bar[XB_XGEN(b.x)], 1u);
            asm volatile("s_waitcnt vmcnt(0)" ::: "memory");
        } else {
            XB_SPIN(xb_ld(&bar[XB_XGEN(b.x)]) == gen, bar);
            __builtin_amdgcn_fence(__ATOMIC_ACQUIRE, "agent");
            asm volatile("s_waitcnt vmcnt(0)" ::: "memory");
        }
    }
    __syncthreads();
}

struct Args {
    const float* in[26]; float* out; unsigned char* ws; int ph_lo, ph_hi, layer_lo, layer_hi;
};
enum { I_X = 0, I_P, I_WIN, I_CAW, I_CAB, I_LCW, I_LCB, I_LWA, I_LBA, I_LWX, I_LBX, I_LAM, I_CPOS, I_PW1, I_PB1, I_PW2, I_WBR, I_WOUT, I_LNG, I_LNB, I_WR, I_BR, I_WGU, I_WDN, I_WPLE, I_WPG };

struct Frame {
    LAS unsigned char* lds;
    gu32* ctl;
    unsigned char* ws;
    int tid, lane, wave, G, bx;
};
__device__ __forceinline__ const float* inp(const Frame& F, int i) {
    const LAS unsigned* p = (const LAS unsigned*)(F.lds + PTR_OFF) + 2 * i;
    const unsigned lo = __builtin_amdgcn_readfirstlane(p[0]), hi = __builtin_amdgcn_readfirstlane(p[1]);
    return (const float*)(((unsigned long long)hi << 32) | lo);
}
#define PHASE_FENCE() do { asm volatile("" ::: "memory"); unsigned _ones = ~0u; asm volatile("" : "+s"(_ones)); int _t = wave0 * 64 + (int)__builtin_amdgcn_mbcnt_hi(_ones, __builtin_amdgcn_mbcnt_lo(_ones, 0u)); asm volatile("" : "+v"(_t)); F.tid = _t; F.lane = _t & 63; F.wave = __builtin_amdgcn_readfirstlane(_t >> 6); \
    F.ws = (unsigned char*)inp(F, 27); F.ctl = (gu32*)(F.ws + WS_CTL); } while (0)

struct CvtD { const float* src; bf16* dst; int ldw; int K; };
__device__ __forceinline__ void cvt_load(const CvtD& d, f32x4 (&v)[8], int lane) {
    const float* src = d.src + (size_t)(lane >> 3) * d.ldw + 4 * (lane & 7);
#pragma unroll
    for (int i = 0; i < 8; ++i) v[i] = *(const f32x4*)(src + (size_t)(8 * i) * d.ldw);
}
__device__ __forceinline__ void cvt_store(const CvtD& d, const f32x4 (&v)[8], LAS float* scr, int lane) {
#pragma unroll
    for (int i = 0; i < 8; ++i) { LAS float* p = scr + (8 * i + (lane >> 3)) * 33 + 4 * (lane & 7); p[0] = v[i][0]; p[1] = v[i][1]; p[2] = v[i][2]; p[3] = v[i][3]; }
    LDS_WAIT(); asm volatile("" ::: "memory");
    const int c = lane & 7;
#pragma unroll
    for (int j = 0; j < 4; ++j) { const int n = (lane >> 3) + 8 * j; const LAS float* sp = scr + (8 * c) * 33 + n;
        u32x4 o; o.x = pk2(sp[0 * 33], sp[1 * 33]); o.y = pk2(sp[2 * 33], sp[3 * 33]); o.z = pk2(sp[4 * 33], sp[5 * 33]); o.w = pk2(sp[6 * 33], sp[7 * 33]);
        *(GAS u32x4*)(d.dst + (size_t)n * d.K + 8 * c) = o; }
    LDS_WAIT(); asm volatile("" ::: "memory");
}
__device__ __forceinline__ CvtD cvt_desc(const float* W, int ldw, int k0, int n0, bf16* WT, int K, int row0) { CvtD d; d.src = W + (size_t)k0 * ldw + n0; d.dst = WT + (size_t)row0 * K + k0; d.ldw = ldw; d.K = K; return d; }

constexpr int CI_IN = 32 * 434, CI_BRI = 16 * 64, CI_OUT = 32 * 64, CI_GU = 32 * 64, CI_DN = 16 * 64, CI_PGI = 32 * 64, CI_PL = 4 * 64, CI_P1 = 32 * 4, CI_P2 = 2 * 2;
constexpr int CI_PER_LAYER = CI_IN + 3 * CI_BRI + CI_OUT + NE * CI_GU + NE * CI_DN + CI_PGI + CI_PL + 2 * CI_P1 + 2 * CI_P2;
__device__ __forceinline__ CvtD cvt_decode(Frame& F, int it) {
    const int l = it / CI_PER_LAYER; int r = it - l * CI_PER_LAYER;
    unsigned char* lwp = F.ws + WS_W + (size_t)l * LW_BYTES;
    if (r < CI_IN) { const int kb = r / 434, nb = r - kb * 434; int n0, row0;
        if (nb < 242) { n0 = 32 * nb; row0 = n0; } else { n0 = 7728 + 32 * (nb - 242); row0 = Z_MG + 32 * (nb - 242); }
        return cvt_desc(inp(F, I_WIN) + (size_t)l * DM * IN_COLS, IN_COLS, 64 * kb, n0, (bf16*)(lwp + LW_IN), DM, row0); }
    r -= CI_IN;
    if (r < 3 * CI_BRI) { const int bi = r / CI_BRI; r -= bi * CI_BRI; const int kb = r / 64, nb = r % 64;
        return cvt_desc(inp(F, I_WBR) + ((size_t)l * 3 + bi) * BW * DM, DM, 64 * kb, 32 * nb, (bf16*)(lwp + LW_BR) + (size_t)bi * BW, 3 * BW, 32 * nb); }
    r -= 3 * CI_BRI;
    if (r < CI_OUT) { const int kb = r / 64, nb = r % 64; return cvt_desc(inp(F, I_WOUT) + (size_t)l * DM * DM, DM, 64 * kb, 32 * nb, (bf16*)(lwp + LW_OUT), DM, 32 * nb); }
    r -= CI_OUT;
    if (r < NE * CI_GU) { const int e = r / CI_GU; r -= e * CI_GU; const int kb = r / 64, nb = r % 64; const int n = 32 * nb; int row0;
        if (n < DE) row0 = (n >> 7) * 256 + (n & 127); else row0 = ((n - DE) >> 7) * 256 + 128 + ((n - DE) & 127);
        return cvt_desc(inp(F, I_WGU) + ((size_t)l * NE + e) * DM * 2048, 2048, 64 * kb, n, (bf16*)(lwp + LW_GU) + (size_t)e * 2048 * DM, DM, row0); }
    r -= NE * CI_GU;
    if (r < NE * CI_DN) { const int e = r / CI_DN; r -= e * CI_DN; const int kb = r / 64, nb = r % 64;
        return cvt_desc(inp(F, I_WDN) + ((size_t)l * NE + e) * DE * DM, DM, 64 * kb, 32 * nb, (bf16*)(lwp + LW_DN) + (size_t)e * DM * DE, DE, 32 * nb); }
    r -= NE * CI_DN;
    if (r < CI_PGI) { const int kb = r / 64, nb = r % 64; return cvt_desc(inp(F, I_WPG) + (size_t)l * DM * DM, DM, 64 * kb, 32 * nb, (bf16*)(lwp + LW_PG), DM, 32 * nb); }
    r -= CI_PGI;
    if (r < CI_PL) { const int kb = r / 64, nb = r % 64; return cvt_desc(inp(F, I_WPLE) + (size_t)l * PLE * DM, DM, 64 * kb, 32 * nb, (bf16*)(lwp + LW_PLE), PLE, 32 * nb); }
    r -= CI_PL;
    if (r < 2 * CI_P1) { const int kv = r / CI_P1; r -= kv * CI_P1; const int kb = r / 4, nb = r % 4;
        return cvt_desc(inp(F, I_PW1) + ((size_t)l * 2 + kv) * 2048 * 128, 128, 64 * kb, 32 * nb, (bf16*)(lwp + LW_PHI1) + (size_t)kv * 128 * 2048, 2048, 32 * nb); }
    r -= 2 * CI_P1;
    { const int kv = r / CI_P2; r -= kv * CI_P2; const int kb = r / 2, nb = r % 2;
        return cvt_desc(inp(F, I_PW2) + ((size_t)l * 2 + kv) * 128 * 64, 64, 64 * kb, 32 * nb, (bf16*)(lwp + LW_PHI2) + (size_t)kv * 64 * 128, 128, 32 * nb); }
}

__device__ __forceinline__ void p0_prologue(const Args& a, Frame& F) {
    LAS float* scr = (LAS float*)(F.lds + RING_OFF + F.wave * 16384);
    const int gw = F.bx * NWAVES + F.wave, NGW = F.G * NWAVES;
    { int it = gw;
        if (it < DEPTH * CI_PER_LAYER) { CvtD d = cvt_decode(F, it); f32x4 v[8]; cvt_load(d, v, F.lane);
            for (;;) { const int itn = it + NGW; const bool more = itn < DEPTH * CI_PER_LAYER; CvtD dn = d; f32x4 vn[8];
                if (more) { dn = cvt_decode(F, itn); cvt_load(dn, vn, F.lane); }
                cvt_store(d, v, scr, F.lane);
                if (!more) break;
                d = dn; it = itn;
#pragma unroll
                for (int i = 0; i < 8; ++i) v[i] = vn[i]; } } }
    const size_t gt = (size_t)F.bx * NTHR + F.tid, NGT = (size_t)F.G * NTHR;
    for (size_t i = gt; i < (size_t)DEPTH * 192 * DM / 8; i += NGT) { const int l = (int)(i / (192 * DM / 8)); const size_t r = i % (192 * DM / 8);
        *(GAS u32x4*)((bf16*)(F.ws + WS_W + (size_t)l * LW_BYTES + LW_IN) + (size_t)7744 * DM + r * 8) = (u32x4){0u, 0u, 0u, 0u}; }
    const float* pLWA = inp(F, I_LWA); const float* pLWX = inp(F, I_LWX);
    { const size_t nl = (size_t)DEPTH * 8 * 256 * 128;
      for (size_t i0 = gt; i0 < nl; i0 += 4 * NGT) { float v[4];
#pragma unroll
          for (int q = 0; q < 4; ++q) { size_t i = i0 + q * NGT; if (i >= nl) i = gt; const int k = (int)(i & 127), np = (int)((i >> 7) & 255), h = (int)((i >> 15) & 7), l = (int)(i >> 18);
              const int sel = (np >> 4) & 1, j = (np >> 5) * 16 + (np & 15);
              v[q] = *(const GAS float*)((sel ? pLWX : pLWA) + (((size_t)l * 8 + h) * 128 + k) * 128 + j); }
#pragma unroll
          for (int q = 0; q < 4; ++q) { const size_t i = i0 + q * NGT; if (i < nl) { const int k = (int)(i & 127), np = (int)((i >> 7) & 255), h = (int)((i >> 15) & 7), l = (int)(i >> 18);
              ((bf16*)(F.ws + WS_W + (size_t)l * LW_BYTES + LW_LRU))[((size_t)h * 256 + np) * 128 + k] = (bf16)f2bf(v[q]); } } } }
    { const GAS f32x4* x4 = (const GAS f32x4*)inp(F, I_X); GAS u32x2* o = (GAS u32x2*)(F.ws + WS_XB); GAS u32x2* oh = (GAS u32x2*)(F.ws + WS_XH);
      const size_t nx4 = (size_t)T * DM / 4;
      for (size_t i0 = gt; i0 < nx4; i0 += 8 * NGT) { f32x4 v[8];
#pragma unroll
          for (int q = 0; q < 8; ++q) { const size_t i = i0 + q * NGT; v[q] = x4[i < nx4 ? i : gt]; }
#pragma unroll
          for (int q = 0; q < 8; ++q) { const size_t i = i0 + q * NGT; if (i < nx4) { u32x2 w; w.x = pk2(v[q][0], v[q][1]); w.y = pk2(v[q][2], v[q][3]); o[i] = w; u32x2 wh; wh.x = pkh2(v[q][0], v[q][1]); wh.y = pkh2(v[q][2], v[q][3]); oh[i] = wh; } } }
      const GAS f32x4* p4 = (const GAS f32x4*)inp(F, I_P); GAS u32x2* po = (GAS u32x2*)(F.ws + WS_PB);
      const size_t np4 = (size_t)DEPTH * T * PLE / 4;
      for (size_t i0 = gt; i0 < np4; i0 += 8 * NGT) { f32x4 v[8];
#pragma unroll
          for (int q = 0; q < 8; ++q) { const size_t i = i0 + q * NGT; v[q] = p4[i < np4 ? i : gt]; }
#pragma unroll
          for (int q = 0; q < 8; ++q) { const size_t i = i0 + q * NGT; if (i < np4) { u32x2 w; w.x = pk2(v[q][0], v[q][1]); w.y = pk2(v[q][2], v[q][3]); po[i] = w; } } } }
    if (gt < (size_t)DEPTH * 2 * 16 * 128) { const int c = (int)(gt & 127), sl = (int)((gt >> 7) & 15), kv = (int)((gt >> 11) & 1), l = (int)(gt >> 12);
        const float* pos = inp(F, I_CPOS) + ((size_t)l * 2 + kv) * 2048 + sl * 128; const float* w1 = inp(F, I_PW1) + (((size_t)l * 2 + kv) * 2048 + sl * 128) * 128;
        float s = sl == 0 ? inp(F, I_PB1)[((size_t)l * 2 + kv) * 128 + c] : 0.f;
#pragma unroll 32
        for (int k = 0; k < 128; ++k) s += pos[k] * w1[(size_t)k * 128 + c];
        ((float*)(F.ws + WS_SMALL))[gt] = s; }
}

__device__ __forceinline__ float b1eff_sum(const float* p, int c) { float v[16], s = 0.f;
#pragma unroll
    for (int i = 0; i < 16; ++i) v[i] = *(const GAS float*)(p + i * 128 + c);
#pragma unroll
    for (int i = 0; i < 16; ++i) s += v[i];
    return s; }

__device__ __forceinline__ void conv_a_phase(const Args& a, Frame& F, int l) {
    const bf16* Z = (const bf16*)(F.ws + WS_Z); bf16* YA = (bf16*)(F.ws + WS_YA);
    const float* cw = inp(F, I_CAW) + (size_t)l * 3 * BW; const float* cb = inp(F, I_CAB) + (size_t)l * BW;
    const size_t gt = (size_t)F.bx * NTHR + F.tid, NGT = (size_t)F.G * NTHR;
    for (size_t it = gt; it < (size_t)(T / 8) * (BW / 8); it += NGT) {
        const int c0 = (int)(it & 127) * 8, row0 = (int)(it >> 7) * 8, t0 = row0 & (SEQ - 1);
        float w0[8], w1[8], w2[8], bb[8];
        { const f32x4 a0 = *(const GAS f32x4*)(cw + c0), a1 = *(const GAS f32x4*)(cw + c0 + 4), b0 = *(const GAS f32x4*)(cw + BW + c0), b1 = *(const GAS f32x4*)(cw + BW + c0 + 4), c0v = *(const GAS f32x4*)(cw + 2 * BW + c0), c1v = *(const GAS f32x4*)(cw + 2 * BW + c0 + 4), d0 = *(const GAS f32x4*)(cb + c0), d1 = *(const GAS f32x4*)(cb + c0 + 4);
#pragma unroll
            for (int j = 0; j < 4; ++j) { w0[j] = a0[j]; w0[4 + j] = a1[j]; w1[j] = b0[j]; w1[4 + j] = b1[j]; w2[j] = c0v[j]; w2[4 + j] = c1v[j]; bb[j] = d0[j]; bb[4 + j] = d1[j]; } }
        float pm2[8], pm1[8];
#pragma unroll
        for (int j = 0; j < 8; ++j) { pm2[j] = 0.f; pm1[j] = 0.f; }
        if (t0 > 0) {
#pragma unroll
            for (int k = 0; k < 2; ++k) { const bf16* zr = Z + (size_t)(row0 - 2 + k) * NZ; const u32x4 ai = *(const GAS u32x4*)(zr + Z_AIN + c0), ac = *(const GAS u32x4*)(zr + Z_AC + c0);
                const unsigned aiw[4] = {ai.x, ai.y, ai.z, ai.w}, acw[4] = {ac.x, ac.y, ac.z, ac.w};
#pragma unroll
                for (int j = 0; j < 4; ++j) { const float lo = bflo(aiw[j]) * bflo(acw[j]), hi = bfhi(aiw[j]) * bfhi(acw[j]); if (k == 0) { pm2[2 * j] = lo; pm2[2 * j + 1] = hi; } else { pm1[2 * j] = lo; pm1[2 * j + 1] = hi; } } } }
        u32x4 aiv[8], acv[8], abv[8];
#pragma unroll
        for (int tt = 0; tt < 8; ++tt) { const bf16* zr = Z + (size_t)(row0 + tt) * NZ; aiv[tt] = *(const GAS u32x4*)(zr + Z_AIN + c0); acv[tt] = *(const GAS u32x4*)(zr + Z_AC + c0); abv[tt] = *(const GAS u32x4*)(zr + Z_AB + c0); }
#pragma unroll
        for (int tt = 0; tt < 8; ++tt) { const u32x4 ai = aiv[tt], ac = acv[tt], ab = abv[tt];
            const unsigned aiw[4] = {ai.x, ai.y, ai.z, ai.w}, acw[4] = {ac.x, ac.y, ac.z, ac.w}, abw[4] = {ab.x, ab.y, ab.z, ab.w};
            float p0[8]; unsigned ow[4];
#pragma unroll
            for (int j = 0; j < 4; ++j) { p0[2 * j] = bflo(aiw[j]) * bflo(acw[j]); p0[2 * j + 1] = bfhi(aiw[j]) * bfhi(acw[j]); }
#pragma unroll
            for (int j = 0; j < 4; ++j) { const float y0 = bb[2 * j] + w0[2 * j] * pm2[2 * j] + w1[2 * j] * pm1[2 * j] + w2[2 * j] * p0[2 * j], y1 = bb[2 * j + 1] + w0[2 * j + 1] * pm2[2 * j + 1] + w1[2 * j + 1] * pm1[2 * j + 1] + w2[2 * j + 1] * p0[2 * j + 1];
                ow[j] = pk2(y0 * bflo(abw[j]), y1 * bfhi(abw[j])); }
#pragma unroll
            for (int j = 0; j < 8; ++j) { pm2[j] = pm1[j]; pm1[j] = p0[j]; }
            *(GAS u32x4*)(YA + (size_t)(row0 + tt) * YP + c0) = (u32x4){ow[0], ow[1], ow[2], ow[3]}; }
    }
}

template <int PASS>
__device__ __forceinline__ void lru_phase(const Args& a, Frame& F, int l) {
    const bf16* Z = (const bf16*)(F.ws + WS_Z); GAS bf16* YB = (GAS bf16*)(F.ws + WS_YA) + 1024;
    float* aggA = (float*)(F.ws + WS_AGG); float* aggB = aggA + (size_t)BATCH * 8 * BW;
    const bf16* WL = (const bf16*)(F.ws + WS_W + (size_t)l * LW_BYTES + LW_LRU);
    const float* cw = inp(F, I_LCW) + (size_t)l * 4 * BW; const float* cb = inp(F, I_LCB) + (size_t)l * BW;
    const float* ba = inp(F, I_LBA) + (size_t)l * BW; const float* bx = inp(F, I_LBX) + (size_t)l * BW; const float* lam = inp(F, I_LAM) + (size_t)l * BW;
    LAS unsigned char* lds = F.lds + RING_OFF;
    LAS bf16* XA = (LAS bf16*)lds;
    LAS float* XC = (LAS float*)(lds + 17408);
    LAS float* AA = (LAS float*)(lds + 17408 + 32768);
    LAS float* GG = (LAS float*)(lds + 17408 + 65536);
    const int w = F.wave, lane = F.lane, fr = lane & 15, fq = lane >> 4;
    for (int wu = F.bx; wu < BATCH * 8 * 8; wu += F.G) {
        const int h = wu & 7, cg = (wu >> 3) & 7, b = wu >> 6;
        bf16x8 Bf[2][4];
#pragma unroll
        for (int nt = 0; nt < 2; ++nt)
#pragma unroll
            for (int ks = 0; ks < 4; ++ks) Bf[nt][ks] = *(const bf16x8*)(WL + ((size_t)h * 256 + 32 * w + 16 * nt + fr) * 128 + 32 * ks + 8 * fq);
        int jch = F.tid & 127, qd = F.tid >> 7; const int chs = h * 128 + jch;
        LAS float* QA = (LAS float*)(lds + 17408 + 98304);
        LAS float* QB = QA + 512; LAS float* HC = QA + 1024; LAS float* PA = QA + 1280;
        if (F.tid < 128) { float hv0 = 0.f;
            if (PASS == 2) { for (int gg = 0; gg < cg; ++gg) hv0 = aggA[((size_t)b * 8 + gg) * BW + chs] * hv0 + aggB[((size_t)b * 8 + gg) * BW + chs]; }
            HC[jch] = hv0; PA[jch] = 1.f; }
        LAS float* CWL = PA + 256;
        { int ti = F.tid; asm volatile("" : "+v"(ti)); for (int i = ti; i < 640; i += NTHR) CWL[i] = i < 512 ? *(const GAS float*)(cw + (size_t)(i >> 7) * BW + h * 128 + (i & 127)) : *(const GAS float*)(cb + h * 128 + (i - 512)); }
        float bav_u, bxv_u, sp_u;
        { const int ch = h * 128 + 16 * w + fr; bav_u = *(const GAS float*)(ba + ch); bxv_u = *(const GAS float*)(bx + ch); const float lm = *(const GAS float*)(lam + ch);
            sp_u = (lm > 15.f) ? __expf(-lm) : log1pf(__expf(-lm)); }
        __syncthreads();
        u32x4 rv[4][2];
#define LRU1_LOAD(ci_) do { int tp_ = F.tid; asm volatile("" : "+v"(tp_)); const int row_ = tp_ >> 3, cb_ = h * 128 + (tp_ & 7) * 16; \
            _Pragma("unroll") for (int k_ = 0; k_ < 4; ++k_) { const int tt_ = (8 * cg + (ci_)) * 64 + row_ - 3 + k_; \
                if (tt_ >= 0) { const bf16* zr_ = Z + (size_t)(b * SEQ + tt_) * NZ + Z_RIN + cb_; rv[k_][0] = *(const GAS u32x4*)zr_; rv[k_][1] = *(const GAS u32x4*)(zr_ + 8); } \
                else { rv[k_][0] = (u32x4){0u, 0u, 0u, 0u}; rv[k_][1] = (u32x4){0u, 0u, 0u, 0u}; } } } while (0)
        LRU1_LOAD(0);
        for (int ci = 0; ci < 8; ++ci) {
            const int c = 8 * cg + ci, t0 = c * 64;
            int tl = F.tid; asm volatile("" : "+v"(tl)); jch = tl & 127; qd = tl >> 7;
            { const int row = tl >> 3, seg = tl & 7, cbase = h * 128 + seg * 16;
                float xc[16];
#pragma unroll
                for (int j = 0; j < 4; ++j) { const f32x4 v = *(const LAS f32x4*)(CWL + 512 + seg * 16 + 4 * j); xc[4 * j] = v[0]; xc[4 * j + 1] = v[1]; xc[4 * j + 2] = v[2]; xc[4 * j + 3] = v[3]; }
#pragma unroll
                for (int k = 0; k < 4; ++k) {
                    { const u32x4 v0 = rv[k][0], v1 = rv[k][1];
                        const unsigned vw[8] = {v0.x, v0.y, v0.z, v0.w, v1.x, v1.y, v1.z, v1.w};
                        float wk[16];
#pragma unroll
                        for (int j = 0; j < 4; ++j) { const f32x4 v = *(const LAS f32x4*)(CWL + k * 128 + seg * 16 + 4 * j); wk[4 * j] = v[0]; wk[4 * j + 1] = v[1]; wk[4 * j + 2] = v[2]; wk[4 * j + 3] = v[3]; }
#pragma unroll
                        for (int j = 0; j < 8; ++j) { xc[2 * j] += wk[2 * j] * bflo(vw[j]); xc[2 * j + 1] += wk[2 * j + 1] * bfhi(vw[j]); } } }
#pragma unroll
                for (int j = 0; j < 4; ++j) *(LAS f32x4*)(XC + row * 128 + seg * 16 + 4 * j) = (f32x4){xc[4 * j], xc[4 * j + 1], xc[4 * j + 2], xc[4 * j + 3]};
#pragma unroll
                for (int j = 0; j < 4; ++j) *(LAS u32x2*)(XA + row * 136 + seg * 16 + 4 * j) = (u32x2){pk2(xc[4 * j], xc[4 * j + 1]), pk2(xc[4 * j + 2], xc[4 * j + 3])};
                if (ci + 1 < 8) LRU1_LOAD(ci + 1);
                if (PASS == 2) { const bf16* zr = Z + (size_t)(b * SEQ + t0 + row) * NZ + Z_RG + cbase; const u32x4 v0 = *(const GAS u32x4*)zr, v1 = *(const GAS u32x4*)(zr + 8);
                    const unsigned vw[8] = {v0.x, v0.y, v0.z, v0.w, v1.x, v1.y, v1.z, v1.w};
#pragma unroll
                    for (int j = 0; j < 4; ++j) *(LAS f32x4*)(GG + row * 128 + seg * 16 + 4 * j) = (f32x4){gelu_tanh(bflo(vw[2 * j])), gelu_tanh(bfhi(vw[2 * j])), gelu_tanh(bflo(vw[2 * j + 1])), gelu_tanh(bfhi(vw[2 * j + 1]))}; }
            }
            __syncthreads();
            f32x4 acc[4][2];
#pragma unroll
            for (int m = 0; m < 4; ++m) { acc[m][0] = (f32x4){0.f, 0.f, 0.f, 0.f}; acc[m][1] = (f32x4){0.f, 0.f, 0.f, 0.f}; }
#pragma unroll
            for (int ks = 0; ks < 4; ++ks)
#pragma unroll
                for (int m = 0; m < 4; ++m) { const bf16x8 Af = *(const LAS bf16x8*)(XA + (16 * m + fr) * 136 + 32 * ks + 8 * fq);
                    acc[m][0] = __builtin_amdgcn_mfma_f32_16x16x32_bf16(Af, Bf[0][ks], acc[m][0], 0, 0, 0);
                    acc[m][1] = __builtin_amdgcn_mfma_f32_16x16x32_bf16(Af, Bf[1][ks], acc[m][1], 0, 0, 0); }
            { const int j = 16 * w + fr; const float bav = bav_u, bxv = bxv_u, sp = sp_u;
#pragma unroll
                for (int m = 0; m < 4; ++m)
#pragma unroll
                    for (int r = 0; r < 4; ++r) { const int tt = 16 * m + 4 * fq + r;
                        const float rr = sigmoidf_(acc[m][0][r] + bav), ii = sigmoidf_(acc[m][1][r] + bxv);
                        const float la = -8.0f * rr * sp; const float av = __expf(la); const float mult = __builtin_amdgcn_sqrtf(neg_expm1f(2.0f * la));
                        const float xcv = XC[tt * 128 + j]; (void)av; AA[tt * 128 + j] = (float)(_Float16)la; XC[tt * 128 + j] = (float)(_Float16)(mult * ii * xcv); } }
            __syncthreads();
            if (PASS == 1) { const int row = tl >> 3, seg = tl & 7; unsigned short* LAg = (unsigned short*)(F.ws + WS_LA) + ((size_t)b * SEQ + t0 + row) * BW + h * 128 + seg * 16; unsigned short* LBg = (unsigned short*)(F.ws + WS_LB) + ((size_t)b * SEQ + t0 + row) * BW + h * 128 + seg * 16;
#pragma unroll
                for (int j = 0; j < 2; ++j) { float va[8], vb[8];
#pragma unroll
                    for (int e = 0; e < 8; ++e) { va[e] = AA[row * 128 + seg * 16 + 8 * j + e]; vb[e] = XC[row * 128 + seg * 16 + 8 * j + e]; }
                    *(GAS u32x4*)(LAg + 8 * j) = pack8h(va); *(GAS u32x4*)(LBg + 8 * j) = pack8h(vb); } }
            { float qa = 1.f, qb = 0.f;
#pragma unroll
                for (int tt = 16 * qd; tt < 16 * qd + 16; ++tt) { const float av = __expf(AA[tt * 128 + jch]); qb = av * qb + XC[tt * 128 + jch]; qa *= av; }
                QA[qd * 128 + jch] = qa; QB[qd * 128 + jch] = qb; }
            __syncthreads();
            { float hq = HC[(ci & 1) * 128 + jch];
                for (int qq = 0; qq < qd; ++qq) hq = QA[qq * 128 + jch] * hq + QB[qq * 128 + jch];
                if (PASS == 2) {
#pragma unroll
                    for (int tt = 16 * qd; tt < 16 * qd + 16; ++tt) { hq = __expf(AA[tt * 128 + jch]) * hq + XC[tt * 128 + jch];
                        YB[((size_t)b * SEQ + t0 + tt) * YP + chs] = (bf16)f2bf(hq * GG[tt * 128 + jch]); }
                    if (qd == 3) HC[((ci + 1) & 1) * 128 + jch] = hq;
                } else if (qd == 3) { HC[((ci + 1) & 1) * 128 + jch] = QA[384 + jch] * hq + QB[384 + jch];
                    PA[((ci + 1) & 1) * 128 + jch] = PA[(ci & 1) * 128 + jch] * (QA[jch] * QA[128 + jch]) * (QA[256 + jch] * QA[384 + jch]); } }
            __syncthreads();
        }
#undef LRU1_LOAD
        if (PASS == 1 && F.tid < 128) { aggA[((size_t)b * 8 + cg) * BW + chs] = PA[jch]; aggB[((size_t)b * 8 + cg) * BW + chs] = HC[jch]; }
        __syncthreads();
    }
}

__device__ __forceinline__ void compress_phase(const Args& a, Frame& F, int l) {
    const bf16* Z = (const bf16*)(F.ws + WS_Z); bf16* CMP = (bf16*)(F.ws + WS_CMP);
    LAS float* xs = (LAS float*)(F.lds + RING_OFF);
    LAS float* part = xs + 144 * 64;
    LAS float* hid = part + 4 * 8 * 128;
    for (int task = F.bx; task < 2 * BATCH * NG * 32; task += F.G) {
        const int n8 = task & 31, g = (task >> 5) & 3, b = (task >> 7) & 3, kv = task >> 9;
        const float* w1 = inp(F, I_PW1) + ((size_t)l * 2 + kv) * 2048 * 128; const float* w2 = inp(F, I_PW2) + ((size_t)l * 2 + kv) * 128 * 64;
        const float* b1e = (const float*)(F.ws + WS_SMALL) + ((size_t)l * 2 + kv) * 16 * 128;
        const int tok0 = 128 * n8, zc = (kv ? Z_VC : Z_KC) + g * 64;
        for (int i = F.tid; i < 144 * 64; i += NTHR) { const int tk = tok0 + (i >> 6); xs[i] = tk < SEQ ? bf2f(Z[(size_t)(b * SEQ + tk) * NZ + zc + (i & 63)]) : 0.f; }
        __syncthreads();
        { const int c = F.tid & 127, kq = F.tid >> 7; float acc[8];
#pragma unroll
            for (int i = 0; i < 8; ++i) acc[i] = 0.f;
            for (int k = kq * 512; k < kq * 512 + 512; ++k) { const float wv = w1[(size_t)k * 128 + c]; const int lp = k >> 6, d = k & 63;
#pragma unroll
                for (int i = 0; i < 8; ++i) acc[i] += xs[(16 * i + lp) * 64 + d] * wv; }
#pragma unroll
            for (int i = 0; i < 8; ++i) part[(kq * 8 + i) * 128 + c] = acc[i]; }
        __syncthreads();
        for (int i = F.tid; i < 8 * 128; i += NTHR) { const int c = i & 127; const float s = part[i] + part[1024 + i] + part[2048 + i] + part[3072 + i] + b1eff_sum(b1e, c); hid[i] = gelu_tanh(s); }
        __syncthreads();
        { const int i = F.tid >> 6, d = F.tid & 63; float s = 0.f;
            for (int c = 0; c < 128; ++c) s += hid[i * 128 + c] * w2[c * 64 + d];
            const int n = 8 * n8 + i; if (n >= NCMP) s = 0.f;
            CMP[((((size_t)kv * BATCH + b) * NG + g) * 256 + n) * 64 + d] = (bf16)f2bf(s); }
        __syncthreads();
    }
}

__device__ __forceinline__ void lru_pass2_phase(Frame& F, int l) {
    const bf16* Z = (const bf16*)(F.ws + WS_Z); GAS bf16* YB = (GAS bf16*)(F.ws + WS_YA) + 1024;
    const float* aggA = (const float*)(F.ws + WS_AGG); const float* aggB = aggA + (size_t)BATCH * 8 * BW;
    LAS unsigned char* lds = F.lds + RING_OFF;
    LAS float* XC = (LAS float*)(lds + 17408); LAS float* AA = (LAS float*)(lds + 17408 + 32768); LAS float* GG = (LAS float*)(lds + 17408 + 65536);
    LAS float* QA = (LAS float*)(lds + 17408 + 98304); LAS float* QB = QA + 512; LAS float* HC = QA + 1024;
    for (int wu = F.bx; wu < BATCH * 8 * 8; wu += F.G) {
        const int h = wu & 7, cg = (wu >> 3) & 7, b = wu >> 6;
        u32x4 ra[2], rb[2], rg[2];
#define LRU2_LOAD(ci_) do { int tp_ = F.tid; asm volatile("" : "+v"(tp_)); const int row_ = tp_ >> 3, seg_ = tp_ & 7; const size_t r_ = (size_t)b * SEQ + (8 * cg + (ci_)) * 64 + row_; \
            const unsigned short* LAg_ = (const unsigned short*)(F.ws + WS_LA) + r_ * BW + h * 128 + seg_ * 16; const unsigned short* LBg_ = (const unsigned short*)(F.ws + WS_LB) + r_ * BW + h * 128 + seg_ * 16; const bf16* zr_ = Z + r_ * NZ + Z_RG + h * 128 + seg_ * 16; \
            _Pragma("unroll") for (int j_ = 0; j_ < 2; ++j_) { ra[j_] = *(const GAS u32x4*)(LAg_ + 8 * j_); rb[j_] = *(const GAS u32x4*)(LBg_ + 8 * j_); rg[j_] = *(const GAS u32x4*)(zr_ + 8 * j_); } } while (0)
        LRU2_LOAD(0);
        { const int jch = F.tid & 127, chs = h * 128 + jch;
            if (F.tid < 128) { float ga_[7], gb_[7], hv0 = 0.f;
#pragma unroll
                for (int gg = 0; gg < 7; ++gg) { const int gc = gg < cg ? gg : 0; ga_[gg] = *(const GAS float*)(aggA + ((size_t)b * 8 + gc) * BW + chs); gb_[gg] = *(const GAS float*)(aggB + ((size_t)b * 8 + gc) * BW + chs); }
#pragma unroll
                for (int gg = 0; gg < 7; ++gg) if (gg < cg) hv0 = ga_[gg] * hv0 + gb_[gg];
                HC[jch] = hv0; } }
        for (int ci = 0; ci < 8; ++ci) {
            const int t0 = (8 * cg + ci) * 64;
            int tl = F.tid; asm volatile("" : "+v"(tl)); const int jch = tl & 127, qd = tl >> 7, chs = h * 128 + jch;
            { const int row = tl >> 3, seg = tl & 7;
#pragma unroll
                for (int j = 0; j < 2; ++j) { float va[8], vb[8], vg[8]; unpack8h(ra[j], va); unpack8h(rb[j], vb); unpack8(rg[j], vg);
#pragma unroll
                    for (int e = 0; e < 8; e += 4) { *(LAS f32x4*)(AA + row * 128 + seg * 16 + 8 * j + e) = (f32x4){__expf(va[e]), __expf(va[e + 1]), __expf(va[e + 2]), __expf(va[e + 3])}; *(LAS f32x4*)(XC + row * 128 + seg * 16 + 8 * j + e) = (f32x4){vb[e], vb[e + 1], vb[e + 2], vb[e + 3]};
                        *(LAS f32x4*)(GG + row * 128 + seg * 16 + 8 * j + e) = (f32x4){gelu_tanh(vg[e]), gelu_tanh(vg[e + 1]), gelu_tanh(vg[e + 2]), gelu_tanh(vg[e + 3])}; } } }
            if (ci + 1 < 8) LRU2_LOAD(ci + 1);
            __syncthreads();
            { float qa = 1.f, qb = 0.f;
#pragma unroll
                for (int tt = 16 * qd; tt < 16 * qd + 16; ++tt) { const float av = AA[tt * 128 + jch]; qb = av * qb + XC[tt * 128 + jch]; qa *= av; }
                QA[qd * 128 + jch] = qa; QB[qd * 128 + jch] = qb; }
            __syncthreads();
            { float hq = HC[(ci & 1) * 128 + jch];
                for (int qq = 0; qq < qd; ++qq) hq = QA[qq * 128 + jch] * hq + QB[qq * 128 + jch];
#pragma unroll
                for (int tt = 16 * qd; tt < 16 * qd + 16; ++tt) { hq = AA[tt * 128 + jch] * hq + XC[tt * 128 + jch];
                    YB[((size_t)b * SEQ + t0 + tt) * YP + chs] = (bf16)f2bf(hq * GG[tt * 128 + jch]); }
                if (qd == 3) HC[((ci + 1) & 1) * 128 + jch] = hq; }
            __syncthreads();
        }
#undef LRU2_LOAD
    }
}

__device__ __forceinline__ void knorm_phase(Frame& F) {
    const bf16* Z = (const bf16*)(F.ws + WS_Z); float* KMX = (float*)(F.ws + WS_KMX);
    const int gw = F.bx * NWAVES + F.wave, NGW = F.G * NWAVES;
    for (int task = gw; task < 2 * BATCH * NG * 64; task += NGW) { const int j = task & 63, g = (task >> 6) & 3, b = (task >> 8) & 3, which = task >> 10;
        const bf16* kr = Z + (size_t)(b * SEQ + 64 * j + F.lane) * NZ + (which ? Z_KW : Z_KS) + g * 64; float ss = 0.f;
        u32x4 kv8[8];
#pragma unroll
        for (int i = 0; i < 8; ++i) kv8[i] = *(const GAS u32x4*)(kr + 8 * i);
#pragma unroll
        for (int i = 0; i < 8; ++i) { const u32x4 v = kv8[i]; ss += bflo(v.x) * bflo(v.x) + bfhi(v.x) * bfhi(v.x) + bflo(v.y) * bflo(v.y) + bfhi(v.y) * bfhi(v.y) + bflo(v.z) * bflo(v.z) + bfhi(v.z) * bfhi(v.z) + bflo(v.w) * bflo(v.w) + bfhi(v.w) * bfhi(v.w); }
        ss = wave_max(ss);
        if (F.lane == 0) KMX[task] = sqrtf(ss) * 1.001f; }
}

__device__ __forceinline__ void compress_mfma_phase(Frame& F, int l, bf16* CMP) {
    typedef float f32x16 __attribute__((ext_vector_type(16)));
    const bf16* Z = (const bf16*)(F.ws + WS_Z);
    LAS unsigned char* lds = F.lds + RING_OFF;
    constexpr int XP = 144;
    LAS unsigned char* XS = lds;
    LAS float* RED = (LAS float*)(lds + 76032);
    LAS bf16* HID = (LAS bf16*)(lds + 76032 + 16512);
    const int w = F.wave, lane = F.lane, r32 = lane & 31, h = lane >> 5;
    for (int unit = F.bx; unit < 2 * BATCH * NG * 8; unit += F.G) {
        const int nb = unit & 7, g = (unit >> 3) & 3, b = (unit >> 5) & 3, kv = unit >> 7;
        const bf16* W1T = (const bf16*)(F.ws + WS_W + (size_t)l * LW_BYTES + LW_PHI1) + (size_t)kv * 128 * 2048;
        const bf16* W2T = (const bf16*)(F.ws + WS_W + (size_t)l * LW_BYTES + LW_PHI2) + (size_t)kv * 64 * 128;
        const float* b1e = (const float*)(F.ws + WS_SMALL) + ((size_t)l * 2 + kv) * 16 * 128;
        const int tok0 = 512 * nb, zc = (kv ? Z_VC : Z_KC) + g * 64;
        { u32x4 sv[9];
#pragma unroll
          for (int q = 0; q < 9; ++q) { const int i = F.tid + q * NTHR; const int ti = i >> 3, ch = i & 7, tk = tok0 + ti; const bool ok = i < 528 * 8 && tk < SEQ;
              sv[q] = *(const GAS u32x4*)(Z + (size_t)(b * SEQ + (ok ? tk : 0)) * NZ + zc + 8 * ch); if (!ok) sv[q] = (u32x4){0u, 0u, 0u, 0u}; }
#pragma unroll
          for (int q = 0; q < 9; ++q) { const int i = F.tid + q * NTHR; const int ti = i >> 3, ch = i & 7;
              if (i < 528 * 8) *(LAS u32x4*)(XS + ((ti & 15) * 33 + (ti >> 4)) * XP + ch * 16) = sv[q]; } }
        __syncthreads();
        const int ct = w & 3, lh = w >> 2;
        f32x16 acc;
#pragma unroll
        for (int i = 0; i < 16; ++i) acc[i] = 0.f;
        const bf16* wrow = W1T + (size_t)(32 * ct + r32) * 2048 + 8 * h;
        { bf16x8 wa[4][4], wb[4][4]; const int l0 = 16 * lh;
#define CMP_LOADW(dst, lb) { _Pragma("unroll") for (int q = 0; q < 4; ++q) _Pragma("unroll") for (int ks = 0; ks < 4; ++ks) dst[q][ks] = *(const GAS bf16x8*)(wrow + ((lb) + q) * 64 + 16 * ks); }
#define CMP_MMA(src, lb) { _Pragma("unroll") for (int q = 0; q < 4; ++q) { const int ll = (lb) + q; const LAS unsigned char* xr = XS + ((ll & 15) * 33 + (ll >> 4) + r32) * XP + 16 * h; \
            _Pragma("unroll") for (int ks = 0; ks < 4; ++ks) { const bf16x8 af = *(const LAS bf16x8*)(xr + 32 * ks); acc = __builtin_amdgcn_mfma_f32_32x32x16_bf16(af, src[q][ks], acc, 0, 0, 0); } } }
          CMP_LOADW(wa, l0) CMP_LOADW(wb, l0 + 4) CMP_MMA(wa, l0) CMP_LOADW(wa, l0 + 8) CMP_MMA(wb, l0 + 4) CMP_LOADW(wb, l0 + 12) CMP_MMA(wa, l0 + 8) CMP_MMA(wb, l0 + 12)
#undef CMP_LOADW
#undef CMP_MMA
        }
        if (lh == 1) {
#pragma unroll
            for (int r = 0; r < 16; ++r) RED[((r & 3) + 8 * (r >> 2) + 4 * h) * 129 + 32 * ct + r32] = acc[r]; }
        __syncthreads();
        if (lh == 0) { const float bias = b1eff_sum(b1e, 32 * ct + r32);
#pragma unroll
            for (int r = 0; r < 16; ++r) { const int n = (r & 3) + 8 * (r >> 2) + 4 * h; const float v = acc[r] + RED[n * 129 + 32 * ct + r32] + bias; HID[n * 136 + 32 * ct + r32] = (bf16)f2bf(gelu_tanh(v)); } }
        __syncthreads();
        if (w < 2) {
            f32x16 a2;
#pragma unroll
            for (int i = 0; i < 16; ++i) a2[i] = 0.f;
            bf16x8 w2[8];
#pragma unroll
            for (int ks = 0; ks < 8; ++ks) w2[ks] = *(const GAS bf16x8*)(W2T + (size_t)(32 * w + r32) * 128 + 16 * ks + 8 * h);
#pragma unroll
            for (int ks = 0; ks < 8; ++ks) { const bf16x8 af = *(const LAS bf16x8*)(HID + r32 * 136 + 16 * ks + 8 * h);
                a2 = __builtin_amdgcn_mfma_f32_32x32x16_bf16(af, w2[ks], a2, 0, 0, 0); }
#pragma unroll
            for (int r = 0; r < 16; ++r) { const int n = 32 * nb + (r & 3) + 8 * (r >> 2) + 4 * h; const float v = n < NCMP ? a2[r] : 0.f;
                CMP[((((size_t)kv * BATCH + b) * NG + g) * 256 + n) * 64 + 32 * w + r32] = (bf16)f2bf(v); } }
        __syncthreads();
    }
}

__device__ __forceinline__ float dot64(const unsigned (&qw)[32], const bf16* krow) {
    const u32x4* kp = (const u32x4*)krow; float s = 0.f;
#pragma unroll
    for (int i = 0; i < 8; ++i) { const u32x4 kv = kp[i]; const unsigned kw[4] = {kv.x, kv.y, kv.z, kv.w};
#pragma unroll
        for (int j = 0; j < 4; ++j) { s += bflo(qw[4 * i + j]) * bflo(kw[j]); s += bfhi(qw[4 * i + j]) * bfhi(kw[j]); } }
    return s;
}
#define WAVE_SYNC() do { asm volatile("s_waitcnt lgkmcnt(0)" ::: "memory"); __builtin_amdgcn_wave_barrier(); } while (0)
__device__ __forceinline__ void nsa_naive_phase(const Args& a, Frame& F, int l) {
    const bf16* Z = (const bf16*)(F.ws + WS_Z); bf16* YC = (bf16*)(F.ws + WS_YA) + 2048;
    const bf16* CK = (const bf16*)(F.ws + WS_CMP); const bf16* CV = CK + (size_t)BATCH * NG * 256 * 64;
    LAS float* pl = (LAS float*)(F.lds + RING_OFF) + F.wave * 4096;
    const int lane = F.lane; const int gw = F.bx * NWAVES + F.wave, NGW = F.G * NWAVES;
    for (int task = gw; task < BATCH * NG * SEQ; task += NGW) {
        const int t = task & (SEQ - 1), g = (task >> 12) & 3, b = task >> 14;
        const size_t row = (size_t)b * SEQ + t; const bf16* zrow = Z + row * NZ; const bf16* zb = Z + (size_t)b * SEQ * NZ;
        const bf16* ck = CK + ((size_t)b * NG + g) * 256 * 64; const bf16* cv = CV + ((size_t)b * NG + g) * 256 * 64;
        const int nvis = t >= 31 ? ((t - 31) >> 4) + 1 : 0;
        float ocmp[4], oslc[4], owin[4], ssum[4], wsum[4];
#pragma unroll
        for (int r = 0; r < 4; ++r) { const int h = 4 * g + r; const float slope = exp2f(-0.5f * (float)(h + 1));
            unsigned qw[32]; { const unsigned* qp = (const unsigned*)(zrow + Z_Q + h * 64);
#pragma unroll
                for (int i = 0; i < 32; ++i) qw[i] = qp[i]; }
            float sc[4]; float mx = -INFINITY;
#pragma unroll
            for (int c = 0; c < 4; ++c) { const int n = lane + 64 * c; float s = -INFINITY;
                if (n < nvis) s = dot64(qw, ck + (size_t)n * 64) * 0.125f - slope * (float)(t - 16 * n - 31);
                sc[c] = s; mx = fmaxf(mx, s); }
            mx = wave_max(mx); float sum = 0.f;
#pragma unroll
            for (int c = 0; c < 4; ++c) { const int n = lane + 64 * c; const float p = (n < nvis) ? __expf(sc[c] - mx) : 0.f; sc[c] = p; sum += p; }
            sum = wave_sum(sum); const float inv = nvis > 0 ? 1.0f / sum : 0.f;
#pragma unroll
            for (int c = 0; c < 4; ++c) pl[r * 256 + lane + 64 * c] = sc[c] * inv; }
        WAVE_SYNC();
#pragma unroll
        for (int r = 0; r < 4; ++r) ocmp[r] = 0.f;
        for (int n = 0; n < nvis; ++n) { const float v = bf2f(cv[(size_t)n * 64 + lane]);
#pragma unroll
            for (int r = 0; r < 4; ++r) ocmp[r] += pl[r * 256 + n] * v; }
        float imp = 0.f;
#pragma unroll
        for (int r = 0; r < 4; ++r) { const int n0 = 4 * lane; float s = pl[r * 256 + n0] + pl[r * 256 + n0 + 1] + pl[r * 256 + n0 + 2] + 0.5f * pl[r * 256 + n0 + 3];
            if (lane > 0) s += 0.5f * pl[r * 256 + n0 - 1]; imp += s; }
        WAVE_SYNC();
        const int jt = t >> 6;
        const float val = (lane == 0 || lane == jt) ? 1e9f : (lane <= jt ? imp : -1e9f);
        int rank = 0;
        for (int i = 0; i < 64; ++i) { const float vi = __shfl(val, i); rank += ((vi > val) || (vi == val && i < lane)) ? 1 : 0; }
        const unsigned long long mask = __ballot(rank < TOPN);
#if NSA_XCHK
        if (lane == 0) ((unsigned long long*)(F.ws + WS_PL))[task] = mask;
#endif
#pragma unroll
        for (int r = 0; r < 4; ++r) { const int h = 4 * g + r; const float slope = exp2f(-0.5f * (float)(h + 1));
            unsigned qw[32]; { const unsigned* qp = (const unsigned*)(zrow + Z_Q + h * 64);
#pragma unroll
                for (int i = 0; i < 32; ++i) qw[i] = qp[i]; }
            float ss[16]; float mx = -INFINITY; unsigned long long mm = mask;
#pragma unroll
            for (int bi = 0; bi < 16; ++bi) { const int j = __builtin_ctzll(mm); mm &= mm - 1; const int pos = 64 * j + lane; const int dist = t - pos; float s = -INFINITY;
                if (dist >= 0) s = dot64(qw, zb + (size_t)pos * NZ + Z_KS + g * 64) * 0.125f - slope * (float)dist;
                ss[bi] = s; mx = fmaxf(mx, s); }
            mx = wave_max(mx); float sum = 0.f;
#pragma unroll
            for (int bi = 0; bi < 16; ++bi) { const float p = __expf(ss[bi] - mx); sum += p; pl[r * 1024 + bi * 64 + lane] = p; }
            ssum[r] = wave_sum(sum); }
        WAVE_SYNC();
#pragma unroll
        for (int r = 0; r < 4; ++r) oslc[r] = 0.f;
        { unsigned long long mm = mask;
            for (int bi = 0; bi < 16; ++bi) { const int j = __builtin_ctzll(mm); mm &= mm - 1;
                const int kmax = (t - 64 * j) >= 63 ? 64 : (t - 64 * j + 1);
                for (int k = 0; k < kmax; ++k) { const float v = bf2f(zb[(size_t)(64 * j + k) * NZ + Z_VS + g * 64 + lane]);
#pragma unroll
                    for (int r = 0; r < 4; ++r) oslc[r] += pl[r * 1024 + bi * 64 + k] * v; } } }
        WAVE_SYNC();
#pragma unroll
        for (int r = 0; r < 4; ++r) { const int h = 4 * g + r; const float slope = exp2f(-0.5f * (float)(h + 1));
            unsigned qw[32]; { const unsigned* qp = (const unsigned*)(zrow + Z_Q + h * 64);
#pragma unroll
                for (int i = 0; i < 32; ++i) qw[i] = qp[i]; }
            float ss[8]; float mx = -INFINITY;
#pragma unroll
            for (int c = 0; c < 8; ++c) { const int i = lane + 64 * c; const int pos = t - (WIN - 1) + i; float s = -INFINITY;
                if (pos >= 0) s = dot64(qw, zb + (size_t)pos * NZ + Z_KW + g * 64) * 0.125f - slope * (float)(WIN - 1 - i);
                ss[c] = s; mx = fmaxf(mx, s); }
            mx = wave_max(mx); float sum = 0.f;
#pragma unroll
            for (int c = 0; c < 8; ++c) { const float p = __expf(ss[c] - mx); sum += p; pl[r * 512 + lane + 64 * c] = p; }
            wsum[r] = wave_sum(sum); }
        WAVE_SYNC();
#pragma unroll
        for (int r = 0; r < 4; ++r) owin[r] = 0.f;
        { const int i0 = t >= WIN - 1 ? 0 : (WIN - 1 - t);
            for (int i = i0; i < WIN; ++i) { const int pos = t - (WIN - 1) + i; const float v = bf2f(zb[(size_t)pos * NZ + Z_VW + g * 64 + lane]);
#pragma unroll
                for (int r = 0; r < 4; ++r) owin[r] += pl[r * 512 + i] * v; } }
        WAVE_SYNC();
#pragma unroll
        for (int r = 0; r < 4; ++r) { const int h = 4 * g + r;
            const float g0 = sigmoidf_(bf2f(zrow[Z_NG + h * 3 + 0])), g1 = sigmoidf_(bf2f(zrow[Z_NG + h * 3 + 1])), g2 = sigmoidf_(bf2f(zrow[Z_NG + h * 3 + 2]));
            const float o = g0 * ocmp[r] + g1 * oslc[r] / ssum[r] + g2 * owin[r] / wsum[r];
            YC[row * YP + h * 64 + lane] = (bf16)f2bf(o); }
    }
}

namespace nsa {
typedef float f32x16 __attribute__((ext_vector_type(16)));
typedef short s16x4 __attribute__((ext_vector_type(4)));
constexpr int TB = 8192;
constexpr int L_K = 0, L_V = 3 * TB, L_IMP = 6 * TB, L_MASK = L_IMP + 4 * 64 * 65 * 4, L_KMX = L_MASK + 512  , L_QN = L_KMX + 512  , L_GT = L_QN + 2048  , L_END = L_GT + 6144;
constexpr int L_Y = L_IMP;
static_assert(L_END <= MISC_OFF && 8 * 32 * 64 * 4 <= 4 * 64 * 65 * 4, "nsa lds");
constexpr float LOG2E = 1.4426950408889634f;
__device__ __forceinline__ unsigned cvtpk(float lo, float hi) { typedef float f2 __attribute__((ext_vector_type(2))); typedef __bf16 b2 __attribute__((ext_vector_type(2))); f2 v = {lo, hi}; b2 b = __builtin_convertvector(v, b2); return __builtin_bit_cast(unsigned, b); }
__device__ __forceinline__ s16x4 vtr(const LAS unsigned char* p) { typedef short v4 __attribute__((ext_vector_type(4))); return __builtin_bit_cast(s16x4, __builtin_amdgcn_ds_read_tr16_b64_v4i16((LAS v4*)p)); }
#define MFMA32(a, b, c) __builtin_amdgcn_mfma_f32_32x32x16_bf16((a), (b), (c), 0, 0, 0)

struct Lane { int lane, tq; };

template <int MODE, int MK  , bool FIRST, class ValidF>
__device__ __forceinline__ void tile_compute(const LAS unsigned char* Kb, const LAS unsigned char* Vb, const bf16x8 (&qf)[4], const float c0, const float sbk,
                                             const bool lv, const ValidF& valid, float& m, float& l, f32x16 (&o)[2], LAS float* imp, const Lane& L) {
    int ln = L.lane; asm volatile("" : "+v"(ln));
    const int r32 = ln & 31, hh = ln >> 5;
    unsigned kofs[4], vofs[2];
#pragma unroll
    for (int ks = 0; ks < 4; ++ks) kofs[ks] = (unsigned)(r32 * 128 + (((2 * ks + hh) ^ (r32 & 7)) << 4));
    { const int q4 = (ln & 15) >> 2, p4 = ln & 3, blk = (ln >> 4) & 1, cc0 = 2 * blk + (p4 >> 1), kk = 4 * hh + q4;
#pragma unroll
        for (int dt = 0; dt < 2; ++dt) vofs[dt] = (unsigned)((4 * hh + q4) * 128 + (((cc0 + 4 * dt) ^ kk) << 4) + 8 * (p4 & 1)); }
    f32x16 p[2];
    const float cref = c0 + sbk * (float)(4 * hh) - ((MODE == 2 && !FIRST) || MODE == 1 ? m : 0.f);
#pragma unroll
    for (int mt = 0; mt < 2; ++mt)
#pragma unroll
        for (int r = 0; r < 16; ++r) p[mt][r] = fmaf(sbk, (float)(32 * mt + (r & 3) + 8 * (r >> 2)), cref);
#pragma unroll
    for (int ks = 0; ks < 4; ++ks)
#pragma unroll
        for (int mt = 0; mt < 2; ++mt) { const bf16x8 a = *(const LAS bf16x8*)(Kb + kofs[ks] + mt * 4096); p[mt] = MFMA32(a, qf[ks], p[mt]); }
    if (MK != 0) {
#pragma unroll
        for (int mt = 0; mt < 2; ++mt)
#pragma unroll
            for (int r = 0; r < 16; ++r) { const int kc = 32 * mt + (r & 3) + 8 * (r >> 2); const bool ok = (MK == 2) ? valid(kc + 4 * hh) : lv; p[mt][r] = ok ? p[mt][r] : -INFINITY; } }
    if (MODE != 1) {
        float tmax = fmaxf(p[0][0], p[1][0]);
#pragma unroll
        for (int r = 1; r < 16; ++r) tmax = fmaxf(tmax, fmaxf(p[0][r], p[1][r]));
        tmax = fmaxf(tmax, __shfl_xor(tmax, 32));
        if (MODE == 0) {
            const float mn = fmaxf(m, tmax); const float mm = (mn == -INFINITY) ? 0.f : mn; l *= __builtin_amdgcn_exp2f(m - mm); m = mn;
#pragma unroll
            for (int mt = 0; mt < 2; ++mt)
#pragma unroll
                for (int r = 0; r < 16; ++r) p[mt][r] -= mm;
        } else if (FIRST) {
            m = tmax;
#pragma unroll
            for (int mt = 0; mt < 2; ++mt)
#pragma unroll
                for (int r = 0; r < 16; ++r) p[mt][r] -= tmax;
        } else if (__any(tmax > 8.0f)) {
            const float dl = fmaxf(tmax, 0.f); m += dl; const float f = __builtin_amdgcn_exp2f(-dl); l *= f;
#pragma unroll
            for (int mt = 0; mt < 2; ++mt)
#pragma unroll
                for (int r = 0; r < 16; ++r) p[mt][r] -= dl;
#pragma unroll
            for (int i = 0; i < 16; ++i) { o[0][i] *= f; o[1][i] *= f; } }
    }
    float ls = 0.f;
#pragma unroll
    for (int mt = 0; mt < 2; ++mt)
#pragma unroll
        for (int r = 0; r < 16; ++r) { const float e = __builtin_amdgcn_exp2f(p[mt][r]); p[mt][r] = e; ls += e; }
    l += ls;
    if (MODE == 0) return;
    if (MODE == 1) {
        float av[8], bv[8];
#pragma unroll
        for (int mt = 0; mt < 2; ++mt)
#pragma unroll
            for (int g4 = 0; g4 < 4; ++g4) { const float h3 = 0.5f * p[mt][4 * g4 + 3]; av[mt * 4 + g4] = (p[mt][4 * g4] + p[mt][4 * g4 + 1]) + (p[mt][4 * g4 + 2] + h3); bv[mt * 4 + g4] = h3; }
#pragma unroll
        for (int i = 0; i < 8; ++i) imp[8 * (i >> 2) + 2 * (i & 3) + hh] += av[i];
        asm volatile("s_waitcnt lgkmcnt(0)" ::: "memory"); __builtin_amdgcn_wave_barrier();
#pragma unroll
        for (int i = 0; i < 8; ++i) imp[8 * (i >> 2) + 2 * (i & 3) + hh + 1] += bv[i];
        asm volatile("s_waitcnt lgkmcnt(0)" ::: "memory"); __builtin_amdgcn_wave_barrier();
    }
    bf16x8 pf[2][2];
#pragma unroll
    for (int mt = 0; mt < 2; ++mt)
#pragma unroll
        for (int sg = 0; sg < 2; ++sg) { u32x4 w; w.x = cvtpk(p[mt][8 * sg], p[mt][8 * sg + 1]); w.y = cvtpk(p[mt][8 * sg + 2], p[mt][8 * sg + 3]); w.z = cvtpk(p[mt][8 * sg + 4], p[mt][8 * sg + 5]); w.w = cvtpk(p[mt][8 * sg + 6], p[mt][8 * sg + 7]);
            pf[mt][sg] = __builtin_bit_cast(bf16x8, w); }
#pragma unroll
    for (int dt = 0; dt < 2; ++dt)
#pragma unroll
        for (int mt = 0; mt < 2; ++mt)
#pragma unroll
            for (int sg = 0; sg < 2; ++sg) { const LAS unsigned char* vp = Vb + vofs[dt] + (32 * mt + 16 * sg) * 128;
                const s16x4 lo = vtr(vp), hi = vtr(vp + 8 * 128); const bf16x8 vf = __builtin_shufflevector(lo, hi, 0, 1, 2, 3, 4, 5, 6, 7);
                o[dt] = MFMA32(vf, pf[mt][sg], o[dt]); }
}
}

__device__ __forceinline__ void nsa_mfma_phase(Frame& F, int l, bf16* YC, int ypitch) {
    using namespace nsa;
    const bf16* Z = (const bf16*)(F.ws + WS_Z);
    const bf16* CK = (const bf16*)(F.ws + WS_CMP); const bf16* CV = CK + (size_t)BATCH * NG * 256 * 64;
    LAS unsigned char* lds = F.lds + RING_OFF;
    LAS float* IMP = (LAS float*)(lds + L_IMP); LAS unsigned long long* MASK = (LAS unsigned long long*)(lds + L_MASK);
    const int tid = F.tid, lane = F.lane, w = F.wave;
    Lane L; L.lane = lane; L.tq = 32 * (w & 1) + (lane & 31);
    const int hr = w >> 1;
    const int drow = 8 * w + (lane >> 3), dchk = (lane & 7) ^ ((lane >> 3) & 7);
    const unsigned loffZ = (unsigned)(drow * (NZ * 2) + dchk * 16), loffC = (unsigned)(drow * 128 + dchk * 16);
#define NSA_YL() ({ int lx_ = lane; asm volatile("" : "+v"(lx_)); (LAS float*)(lds + L_Y) + w * 2048 + lx_; })
#define NSA_ROW() ({ int lx_ = lane; asm volatile("" : "+v"(lx_)); (size_t)b * SEQ + 64 * c + 32 * (w & 1) + (lx_ & 31); })
#define NSA_IMPW() ({ int lx_ = lane; asm volatile("" : "+v"(lx_)); IMP + (hr * 64 + 32 * (w & 1) + (lx_ & 31)) * 65; })
    const unsigned ldsb = (unsigned)(size_t)(lds) + (unsigned)w * 1024u;
#define NSA_GLDS(gp, dst) do { unsigned keep_; asm volatile("s_mov_b32 %0, m0\n\ts_mov_b32 m0, %2\n\ts_nop 0\n\tglobal_load_lds_dwordx4 %1, off\n\ts_mov_b32 m0, %0" : "=&s"(keep_) : "v"(gp), "s"(dst) : "memory"); } while (0)
#define NSA_ISSUE(slot, Ksrc, Vsrc, loff) do { unsigned lo_ = (loff); asm volatile("" : "+v"(lo_));     \
        NSA_GLDS((const char*)(Ksrc) + lo_, (unsigned)__builtin_amdgcn_readfirstlane(ldsb + L_K + (slot) * TB)); \
        NSA_GLDS((const char*)(Vsrc) + lo_, (unsigned)__builtin_amdgcn_readfirstlane(ldsb + L_V + (slot) * TB)); } while (0)
#define NSA_WAIT_BAR(n) asm volatile("s_waitcnt vmcnt(" #n ") lgkmcnt(0)\n\ts_barrier" ::: "memory")
    const int vcu = (F.G % 8 == 0) ? (F.bx % 8) * (F.G / 8) + F.bx / 8 : F.bx;
    for (int idx = vcu; idx < BATCH * NG * 64; idx += F.G) {
        const int g = idx >> 8, wv = idx & 255, b = wv >> 6, qq = (wv >> 4) & 3, sx = wv & 15;
        const int cb = 16 * ((qq + (g < 2 ? 2 : 0)) & 3) + sx; const int c = (g & 1) ? 63 - cb : cb;
        const int head = 4 * g + hr; const int t = 64 * c + L.tq; const size_t row = (size_t)b * SEQ + t;
        const float slope2 = exp2f(-0.5f * (float)(head + 1)) * LOG2E; const float scale2 = 0.125f * LOG2E;
        bf16x8 qf[4];
        u32x4 qv4[4]; float kmx_ = 0.f; unsigned short g0_, g1_h, g2_h;
        { int hq = lane; asm volatile("" : "+v"(hq)); const bf16* qp = Z + NSA_ROW() * NZ + Z_Q + head * 64 + 8 * (hq >> 5);
#pragma unroll
          for (int ks = 0; ks < 4; ++ks) qv4[ks] = *(const GAS u32x4*)(qp + 16 * ks);
          int tk = tid; asm volatile("" : "+v"(tk)); if (tk < 128) kmx_ = *(const GAS float*)((const float*)(F.ws + WS_KMX) + (((tk >> 6) * BATCH + b) * NG + g) * 64 + (tk & 63));
          const bf16* gp = Z + NSA_ROW() * NZ + Z_NG + head * 3; g0_ = *(const GAS unsigned short*)(gp); g1_h = *(const GAS unsigned short*)(gp + 1); g2_h = *(const GAS unsigned short*)(gp + 2); }
#pragma unroll
        for (int ks = 0; ks < 4; ++ks) { const u32x4 qv = qv4[ks];
            u32x4 qs; qs.x = cvtpk(bflo(qv.x) * scale2, bfhi(qv.x) * scale2); qs.y = cvtpk(bflo(qv.y) * scale2, bfhi(qv.y) * scale2); qs.z = cvtpk(bflo(qv.z) * scale2, bfhi(qv.z) * scale2); qs.w = cvtpk(bflo(qv.w) * scale2, bfhi(qv.w) * scale2);
            qf[ks] = __builtin_bit_cast(bf16x8, qs); }
        f32x16 o[2];
        const bf16* zb = Z + (size_t)b * SEQ * NZ;
        { float ss = 0.f;
#pragma unroll
            for (int ks = 0; ks < 4; ++ks) { const u32x4 qq = __builtin_bit_cast(u32x4, qf[ks]); ss += bflo(qq.x) * bflo(qq.x) + bfhi(qq.x) * bfhi(qq.x) + bflo(qq.y) * bflo(qq.y) + bfhi(qq.y) * bfhi(qq.y) + bflo(qq.z) * bflo(qq.z) + bfhi(qq.z) * bfhi(qq.z) + bflo(qq.w) * bflo(qq.w) + bfhi(qq.w) * bfhi(qq.w); }
            ss += __shfl_xor(ss, 32); ((LAS float*)(lds + L_QN))[w * 64 + lane] = sqrtf(ss) * 1.001f;
            int tk = tid; asm volatile("" : "+v"(tk)); if (tk < 128) ((LAS float*)(lds + L_KMX))[tk] = kmx_; }
        { int lg_ = lane; asm volatile("" : "+v"(lg_)); LAS float* gt = (LAS float*)(lds + L_GT) + w * 192 + lg_;
            gt[0] = sigmoidf_(__builtin_bit_cast(float, (unsigned)g0_ << 16)); gt[64] = sigmoidf_(__builtin_bit_cast(float, (unsigned)g1_h << 16)); gt[128] = sigmoidf_(__builtin_bit_cast(float, (unsigned)g2_h << 16)); }
        { int ti = tid; asm volatile("" : "+v"(ti)); for (int i = ti; i < 4 * 64 * 65; i += NTHR) IMP[i] = 0.f; }
        asm volatile("s_waitcnt vmcnt(0)" ::: "memory");
        const int nvis = t >= 31 ? ((t - 31) >> 4) + 1 : 0;
        const int ntc = (4 * c + 3 + 63) >> 6;
        const bf16* ckb = CK + ((size_t)b * NG + g) * 256 * 64; const bf16* cvb = CV + ((size_t)b * NG + g) * 256 * 64;
        float m = -INFINITY, lsum = 0.f;
#pragma unroll
        for (int i = 0; i < 16; ++i) { o[0][i] = 0.f; o[1][i] = 0.f; }
        for (int pass = 0; pass < 2; ++pass) {
            const bool fresh = (pass == 0) || (ntc > 3);
            if (fresh) { NSA_ISSUE(0, ckb, cvb, loffC);
                if (ntc > 1) NSA_ISSUE(1, ckb + 64 * 64, cvb + 64 * 64, loffC); }
            for (int tt = 0; tt < ntc; ++tt) {
                if (tt + 1 < ntc) NSA_WAIT_BAR(2); else NSA_WAIT_BAR(0);
                if (fresh && tt + 2 < ntc) NSA_ISSUE((tt + 2) % 3, ckb + (size_t)(tt + 2) * 64 * 64, cvb + (size_t)(tt + 2) * 64 * 64, loffC);
                const int n0 = 64 * tt; int nv = nvis; asm volatile("" : "+v"(nv));
                auto valid = [&](int koff) { return (n0 + koff) < nv; };
                const LAS unsigned char* Kb = lds + L_K + (tt % 3) * TB; const LAS unsigned char* Vb = lds + L_V + (tt % 3) * TB;
                if (pass == 0) tile_compute<0, 2, false>(Kb, Vb, qf, slope2 * 16.f * (float)n0, slope2 * 16.f, true, valid, m, lsum, o, IMP, L);
                else tile_compute<1, 2, false>(Kb, Vb, qf, slope2 * 16.f * (float)n0, slope2 * 16.f, true, valid, m, lsum, o, NSA_IMPW() + 16 * tt, L);
            }
            NSA_WAIT_BAR(0);
            if (pass == 0) { const float lt = lsum + __shfl_xor(lsum, 32); m = (lt > 0.f) ? m + __log2f(lt) : 0.f; lsum = 0.f; }
        }
        if (c < TOPN) { if (lane < 8) MASK[8 * w + lane] = (2ull << c) - 1ull; }
        else
#pragma unroll 1
        for (int i = 0; i < 8; ++i) { int tq = 8 * w + i; asm volatile("" : "+s"(tq)); int ls = lane; asm volatile("" : "+v"(ls)); const float v = (IMP[(0 * 64 + tq) * 65 + ls] + IMP[(1 * 64 + tq) * 65 + ls]) + (IMP[(2 * 64 + tq) * 65 + ls] + IMP[(3 * 64 + tq) * 65 + ls]);
            const unsigned key = (lane == 0 || lane == c) ? 0xFFFFFFFFu : (lane <= c ? __builtin_bit_cast(unsigned, v) + 1u : 0u);
            unsigned cur = 0u;
#pragma unroll
            for (int bit = 31; bit >= 0; --bit) { const unsigned t = cur | (1u << bit); const int cnt = __builtin_popcountll(__ballot(key >= t)); cur = cnt >= TOPN ? t : cur; }
            const unsigned long long gt_ = __ballot(key > cur); unsigned long long eq_ = __ballot(key == cur); const int need = TOPN - __builtin_popcountll(gt_);
            unsigned long long pick = 0ull;
            for (int k = 0; k < need; ++k) { const unsigned long long b1 = eq_ & (0ull - eq_); pick |= b1; eq_ ^= b1; }
            const unsigned long long mk = gt_ | pick;
            if (lane == 0) MASK[tq] = mk; }
#if NSA_XCHK == 1
        __syncthreads();
        if (tid < 64) MASK[tid] = ((const unsigned long long*)(F.ws + WS_PL))[((size_t)(b * NG + g) << 12) + 64 * c + tid];
#endif
        __syncthreads();
        unsigned long long mymask = 0ull, uni_wg, uni_w;
        { int lm = lane; asm volatile("" : "+v"(lm)); const unsigned long long ml = MASK[lm]; unsigned lo = (unsigned)ml, hi = (unsigned)(ml >> 32); unsigned lo2 = ((lane >> 5) == (w & 1)) ? lo : 0u, hi2 = ((lane >> 5) == (w & 1)) ? hi : 0u;
#pragma unroll
            for (int ofs = 1; ofs < 64; ofs <<= 1) { lo |= __shfl_xor(lo, ofs); hi |= __shfl_xor(hi, ofs); lo2 |= __shfl_xor(lo2, ofs); hi2 |= __shfl_xor(hi2, ofs); }
            const unsigned long long causal = (c == 63) ? ~0ull : ((2ull << c) - 1ull);
            uni_wg = (((unsigned long long)(unsigned)__builtin_amdgcn_readfirstlane(hi) << 32) | (unsigned)__builtin_amdgcn_readfirstlane(lo)) & causal;
            uni_w = (((unsigned long long)(unsigned)__builtin_amdgcn_readfirstlane(hi2) << 32) | (unsigned)__builtin_amdgcn_readfirstlane(lo2)) & causal;
            (void)mymask; }
        { float g0; { int lg_ = lane; asm volatile("" : "+v"(lg_)); g0 = ((LAS float*)(lds + L_GT))[w * 192 + lg_]; }
            LAS float* YL = NSA_YL();
#pragma unroll
            for (int i = 0; i < 16; ++i) { YL[64 * i] = g0 * o[0][i]; YL[64 * (16 + i)] = g0 * o[1][i]; } }
        asm volatile("s_waitcnt vmcnt(0)" ::: "memory");
        {
            m = -INFINITY; lsum = 0.f;
#pragma unroll
            for (int i = 0; i < 16; ++i) { o[0][i] = 0.f; o[1][i] = 0.f; }
            unsigned long long rem = uni_wg;
            int j = 63 - __builtin_clzll(rem); rem &= ~(1ull << j);
            NSA_ISSUE(0, zb + (size_t)(64 * j) * NZ + Z_KS + g * 64, zb + (size_t)(64 * j) * NZ + Z_VS + g * 64, loffZ);
            int jn = -1;
            if (rem) { jn = 63 - __builtin_clzll(rem); rem &= ~(1ull << jn); NSA_ISSUE(1, zb + (size_t)(64 * jn) * NZ + Z_KS + g * 64, zb + (size_t)(64 * jn) * NZ + Z_VS + g * 64, loffZ); }
            int slot = 0;
            for (;;) {
                if (jn >= 0) NSA_WAIT_BAR(2); else NSA_WAIT_BAR(0);
                int jnn = -1;
                if (rem) { jnn = 63 - __builtin_clzll(rem); rem &= ~(1ull << jnn); const int s2 = slot >= 1 ? slot - 1 : 2;
                    NSA_ISSUE(s2, zb + (size_t)(64 * jnn) * NZ + Z_KS + g * 64, zb + (size_t)(64 * jnn) * NZ + Z_VS + g * 64, loffZ); }
                bool live = (uni_w >> j) & 1ull;
                unsigned long long mym; { int lq = lane; asm volatile("" : "+v"(lq)); mym = MASK[32 * (w & 1) + (lq & 31)]; }
                if (live && j != c) { const bool selj0 = (mym >> j) & 1ull;
                    const float bound = ((LAS float*)(lds + L_QN))[w * 64 + lane] * ((LAS float*)(lds + L_KMX))[j] + slope2 * (float)(64 * (j - c) + 63) - m; live = !__all(!selj0 || bound < -40.0f); }
                if (live) {
                    const bool selj = (mym >> j) & 1ull; const bool diag = (j == c); int tq = L.tq; asm volatile("" : "+v"(tq));
                    auto valid = [&](int koff) { return selj && (!diag || koff <= tq); };
                    const LAS unsigned char* Kb = lds + L_K + slot * TB; const LAS unsigned char* Vb = lds + L_V + slot * TB;
                    if (diag) tile_compute<2, 2, true>(Kb, Vb, qf, slope2 * (float)(64 * (j - c)), slope2, selj, valid, m, lsum, o, IMP, L);
                    else if (__all(selj)) tile_compute<2, 0, false>(Kb, Vb, qf, slope2 * (float)(64 * (j - c)), slope2, selj, valid, m, lsum, o, IMP, L);
                    else tile_compute<2, 1, false>(Kb, Vb, qf, slope2 * (float)(64 * (j - c)), slope2, selj, valid, m, lsum, o, IMP, L);
                }
                if (jn < 0) break;
                j = jn; jn = jnn; slot = slot == 2 ? 0 : slot + 1;
            }
            const float lt = lsum + __shfl_xor(lsum, 32); float g1_; { int lg_ = lane; asm volatile("" : "+v"(lg_)); g1_ = ((LAS float*)(lds + L_GT))[w * 192 + 64 + lg_]; } const float gi = lt > 0.f ? g1_ / lt : 0.f;
            LAS float* YL = NSA_YL();
#pragma unroll
            for (int i = 0; i < 16; ++i) { YL[64 * i] += gi * o[0][i]; YL[64 * (16 + i)] += gi * o[1][i]; }
            NSA_WAIT_BAR(0);
        }
        {
            m = -INFINITY; lsum = 0.f;
#pragma unroll
            for (int i = 0; i < 16; ++i) { o[0][i] = 0.f; o[1][i] = 0.f; }
            const int jlast = c - 8 > 0 ? c - 8 : 0; int j = c, slot = 0;
            NSA_ISSUE(0, zb + (size_t)(64 * j) * NZ + Z_KW + g * 64, zb + (size_t)(64 * j) * NZ + Z_VW + g * 64, loffZ);
            if (j - 1 >= jlast) NSA_ISSUE(1, zb + (size_t)(64 * (j - 1)) * NZ + Z_KW + g * 64, zb + (size_t)(64 * (j - 1)) * NZ + Z_VW + g * 64, loffZ);
            for (;;) {
                if (j - 1 >= jlast) NSA_WAIT_BAR(2); else NSA_WAIT_BAR(0);
                if (j - 2 >= jlast) { const int s2 = slot >= 1 ? slot - 1 : 2; NSA_ISSUE(s2, zb + (size_t)(64 * (j - 2)) * NZ + Z_KW + g * 64, zb + (size_t)(64 * (j - 2)) * NZ + Z_VW + g * 64, loffZ); }
                bool livew = true;
                if (j != c) { const float bound = ((LAS float*)(lds + L_QN))[w * 64 + lane] * ((LAS float*)(lds + L_KMX))[64 + j] + slope2 * (float)(64 * (j - c) + 63) - m; livew = !__all(bound < -40.0f); }
                if (livew) { const int dj = 64 * (c - j); int tq = L.tq; asm volatile("" : "+v"(tq));
                    auto valid = [&](int koff) { return (dj + tq - koff >= 0) && (dj + tq - koff <= WIN - 1); };
                    const LAS unsigned char* Kb = lds + L_K + slot * TB; const LAS unsigned char* Vb = lds + L_V + slot * TB;
                    if (j == c) tile_compute<2, 2, true>(Kb, Vb, qf, slope2 * (float)(64 * (j - c)), slope2, true, valid, m, lsum, o, IMP, L);
                    else if (j == c - 8) tile_compute<2, 2, false>(Kb, Vb, qf, slope2 * (float)(64 * (j - c)), slope2, true, valid, m, lsum, o, IMP, L);
                    else tile_compute<2, 0, false>(Kb, Vb, qf, slope2 * (float)(64 * (j - c)), slope2, true, valid, m, lsum, o, IMP, L); }
                if (j - 1 < jlast) break;
                --j; slot = slot == 2 ? 0 : slot + 1;
            }
            const float lt = lsum + __shfl_xor(lsum, 32); float g2_; { int lg_ = lane; asm volatile("" : "+v"(lg_)); g2_ = ((LAS float*)(lds + L_GT))[w * 192 + 128 + lg_]; } const float gi = lt > 0.f ? g2_ / lt : 0.f;
            LAS float* YL = NSA_YL();
#pragma unroll
            for (int i = 0; i < 16; ++i) { o[0][i] = YL[64 * i] + gi * o[0][i]; o[1][i] = YL[64 * (16 + i)] + gi * o[1][i]; }
            NSA_WAIT_BAR(0);
        }
        const size_t yrow = NSA_ROW();
#pragma unroll
        for (int dt = 0; dt < 2; ++dt)
#pragma unroll
            for (int g4 = 0; g4 < 4; ++g4) { const int d = 32 * dt + 8 * g4 + 4 * (lane >> 5); u32x2 wv; wv.x = cvtpk(o[dt][4 * g4], o[dt][4 * g4 + 1]); wv.y = cvtpk(o[dt][4 * g4 + 2], o[dt][4 * g4 + 3]);
                *(u32x2*)(YC + yrow * ypitch + head * 64 + d) = wv; }
    }
#undef NSA_ISSUE
#undef NSA_GLDS
#undef NSA_WAIT_BAR
#undef NSA_YL
#undef NSA_IMPW
#undef NSA_ROW
}

__device__ __forceinline__ void merge_phase(const Args& a, Frame& F) {
    const bf16* Z = (const bf16*)(F.ws + WS_Z); const bf16* P = (const bf16*)(F.ws + WS_P); bf16* MB = (bf16*)(F.ws + WS_MB);
    const size_t gt = (size_t)F.bx * NTHR + F.tid, NGT = (size_t)F.G * NTHR;
    for (size_t it = gt; it < (size_t)T * (DM / 8); it += NGT) { const size_t row = it >> 8; const int c0 = (int)(it & 255) * 8;
        float s[8];
#pragma unroll
        for (int j = 0; j < 8; ++j) s[j] = 0.f;
#pragma unroll
        for (int i = 0; i < 3; ++i) { const u32x4 gv = *(const u32x4*)(Z + row * NZ + Z_MG + i * DM + c0), pv = *(const u32x4*)(P + (size_t)i * T * DM + row * DM + c0);
            const unsigned gw[4] = {gv.x, gv.y, gv.z, gv.w}, pw[4] = {pv.x, pv.y, pv.z, pv.w};
#pragma unroll
            for (int j = 0; j < 4; ++j) { s[2 * j] += sigmoidf_(bflo(gw[j])) * bflo(pw[j]); s[2 * j + 1] += sigmoidf_(bfhi(gw[j])) * bfhi(pw[j]); } }
        u32x4 o; o.x = pk2(s[0], s[1]); o.y = pk2(s[2], s[3]); o.z = pk2(s[4], s[5]); o.w = pk2(s[6], s[7]);
        *(u32x4*)(MB + row * DM + c0) = o; }
}

__device__ __forceinline__ void ln_rows(float (&v)[4][8], const float* g, const float* bta, int lane) {
    float s = 0.f;
#pragma unroll
    for (int j = 0; j < 4; ++j)
#pragma unroll
        for (int e = 0; e < 8; ++e) s += v[j][e];
    const float mean = wave_sum(s) * (1.f / DM); float q = 0.f;
#pragma unroll
    for (int j = 0; j < 4; ++j)
#pragma unroll
        for (int e = 0; e < 8; ++e) { v[j][e] -= mean; q += v[j][e] * v[j][e]; }
    const float rstd = 1.0f / sqrtf(wave_sum(q) * (1.f / DM) + LN_EPS);
#pragma unroll
    for (int j = 0; j < 4; ++j) { const f32x4 g0 = *(const GAS f32x4*)(g + 8 * lane + 512 * j), g1 = *(const GAS f32x4*)(g + 8 * lane + 512 * j + 4), b0 = *(const GAS f32x4*)(bta + 8 * lane + 512 * j), b1 = *(const GAS f32x4*)(bta + 8 * lane + 512 * j + 4);
#pragma unroll
        for (int e = 0; e < 4; ++e) { v[j][e] = v[j][e] * rstd * g0[e] + b0[e]; v[j][4 + e] = v[j][4 + e] * rstd * g1[e] + b1[e]; } }
}
__device__ __forceinline__ u32x4 pack8(const float (&o)[8]) { u32x4 w; w.x = pk2(o[0], o[1]); w.y = pk2(o[2], o[3]); w.z = pk2(o[4], o[5]); w.w = pk2(o[6], o[7]); return w; }

__device__ __forceinline__ void route_row(float mylg, const float* br, int row, int ai0, int lane, LAS int* asg_e, LAS int* asg_d, LAS float* asg_g) {
    const float myaff = 1.0f / (1.0f + expf(-mylg));
    float aff[16], sel[16];
#pragma unroll
    for (int e = 0; e < 16; ++e) { aff[e] = __shfl(myaff, e); sel[e] = aff[e] + br[e]; }
    float gs[4];
#pragma unroll
    for (int q = 0; q < 4; ++q) { const float s0 = sel[4 * q], s1 = sel[4 * q + 1], s2 = sel[4 * q + 2], s3 = sel[4 * q + 3];
        gs[q] = fmaxf(fmaxf(fmaxf(s0 + s1, s0 + s2), fmaxf(s0 + s3, s1 + s2)), fmaxf(s1 + s3, s2 + s3)); }
    int best = 0; float bs = gs[0];
#pragma unroll
    for (int q = 1; q < 4; ++q) if (gs[q] > bs) { bs = gs[q]; best = q; }
    float cs[4], ca[4];
#pragma unroll
    for (int i = 0; i < 4; ++i) { cs[i] = best == 0 ? sel[i] : best == 1 ? sel[4 + i] : best == 2 ? sel[8 + i] : sel[12 + i]; ca[i] = best == 0 ? aff[i] : best == 1 ? aff[4 + i] : best == 2 ? aff[8 + i] : aff[12 + i]; }
    int i0 = 0; float m0 = cs[0], a0 = ca[0];
#pragma unroll
    for (int i = 1; i < 4; ++i) if (cs[i] > m0) { m0 = cs[i]; i0 = i; a0 = ca[i]; }
    int i1 = -1; float m1 = -INFINITY, a1 = 0.f;
#pragma unroll
    for (int i = 0; i < 4; ++i) if (i != i0 && cs[i] > m1) { m1 = cs[i]; i1 = i; a1 = ca[i]; }
    if (lane < 2) { const float inv = 1.0f / (a0 + a1); const int ai = ai0 + lane;
        asg_e[ai] = 4 * best + (lane == 0 ? i0 : i1); asg_d[ai] = row * 2 + lane; asg_g[ai] = (lane == 0 ? a0 : a1) * inv; }
}
__device__ __forceinline__ void ln1_router_phase(const Args& a, Frame& F, int l) {
    const unsigned short* PRE = (const unsigned short*)(F.ws + WS_PRE); bf16* X1B = (bf16*)(F.ws + WS_X1B); unsigned short* X1H = (unsigned short*)(F.ws + WS_X1H);
    const float* g = inp(F, I_LNG) + ((size_t)l * 2 + 0) * DM; const float* bta = inp(F, I_LNB) + ((size_t)l * 2 + 0) * DM;
    const float* wr = inp(F, I_WR); const float* br = inp(F, I_BR);
    LAS float* wl = (LAS float*)(F.lds + RING_OFF);
    { f32x4 wv[16];
#pragma unroll
      for (int k = 0; k < 16; ++k) wv[k] = *(const GAS f32x4*)(wr + 4 * (F.tid + NTHR * k));
#pragma unroll
      for (int k = 0; k < 16; ++k) { const int i4 = F.tid + NTHR * k, c = i4 >> 2, e0 = (i4 & 3) * 4;
#pragma unroll
          for (int j = 0; j < 4; ++j) wl[(e0 + j) * DM + c] = wv[k][j]; } }
    __syncthreads();
    const int lane = F.lane; const int gw = F.bx * NWAVES + F.wave, NGW = F.G * NWAVES;
    LAS int* asg_e = (LAS int*)(F.lds + LDSX_OFF); LAS int* asg_d = asg_e + 128; LAS float* asg_g = (LAS float*)(asg_e + 256); LAS int* wgcnt = asg_e + 384; LAS int* wgbase = asg_e + 400;
    int* ldst = (int*)(F.ws + WS_LIST + (size_t)l * 2 * MiB); float* lgate = (float*)(F.ws + WS_LIST + (size_t)l * 2 * MiB + MiB);
    const int niter = (T + NGW - 1) / NGW;
    for (int it = 0; it < niter; it += 2) {
        const int rowA = gw + it * NGW, rowB = gw + (it + 1) * NGW; const int slot = it & 7;
        const bool okA = rowA < T, okB = (it + 1 < niter) && rowB < T; const int rA = okA ? rowA : 0, rB = okB ? rowB : rA;
        if (slot == 0) { if (F.tid < 128) asg_e[F.tid] = -1; __syncthreads(); }
        float va[4][8], vb[4][8];
#pragma unroll
        for (int j = 0; j < 4; ++j) { unpack8h(*(const GAS u32x4*)(PRE + (size_t)rA * DM + 8 * lane + 512 * j), va[j]); unpack8h(*(const GAS u32x4*)(PRE + (size_t)rB * DM + 8 * lane + 512 * j), vb[j]); }
        ln_rows(va, g, bta, lane); ln_rows(vb, g, bta, lane);
        if (okA) {
#pragma unroll
            for (int j = 0; j < 4; ++j) { *(GAS u32x4*)(X1B + (size_t)rA * DM + 8 * lane + 512 * j) = pack8(va[j]); *(GAS u32x4*)(X1H + (size_t)rA * DM + 8 * lane + 512 * j) = pack8h(va[j]); } }
        if (okB) {
#pragma unroll
            for (int j = 0; j < 4; ++j) { *(GAS u32x4*)(X1B + (size_t)rB * DM + 8 * lane + 512 * j) = pack8(vb[j]); *(GAS u32x4*)(X1H + (size_t)rB * DM + 8 * lane + 512 * j) = pack8h(vb[j]); } }
        float lgA = 0.f, lgB = 0.f;
#pragma unroll 1
        for (int e = 0; e < 16; ++e) { float sA = 0.f, sB = 0.f;
#pragma unroll
            for (int j = 0; j < 4; ++j) { const f32x4 w0 = *(const LAS f32x4*)(wl + e * DM + 8 * lane + 512 * j), w1 = *(const LAS f32x4*)(wl + e * DM + 8 * lane + 512 * j + 4);
                sA += (va[j][0] * w0[0] + va[j][1] * w0[1]) + (va[j][2] * w0[2] + va[j][3] * w0[3]) + (va[j][4] * w1[0] + va[j][5] * w1[1]) + (va[j][6] * w1[2] + va[j][7] * w1[3]);
                sB += (vb[j][0] * w0[0] + vb[j][1] * w0[1]) + (vb[j][2] * w0[2] + vb[j][3] * w0[3]) + (vb[j][4] * w1[0] + vb[j][5] * w1[1]) + (vb[j][6] * w1[2] + vb[j][7] * w1[3]); }
            sA = wave_sum(sA); sB = wave_sum(sB); lgA = (lane == e) ? sA : lgA; lgB = (lane == e) ? sB : lgB; }
        if (okA) route_row(lgA, br, rowA, (F.wave * 8 + slot) * 2, lane, asg_e, asg_d, asg_g);
        if (okB) route_row(lgB, br, rowB, (F.wave * 8 + slot + 1) * 2, lane, asg_e, asg_d, asg_g);
        if (slot == 6 || it + 2 >= niter) {
            __syncthreads();
            if (F.tid < 16) wgcnt[F.tid] = 0;
            __syncthreads();
            int me = -1, lp = 0;
            if (F.tid < 128) { me = asg_e[F.tid]; if (me >= 0) lp = __hip_atomic_fetch_add(wgcnt + me, 1, __ATOMIC_RELAXED, __HIP_MEMORY_SCOPE_WORKGROUP); }
            __syncthreads();
            if (F.tid < 16) { const int n = wgcnt[F.tid]; wgbase[F.tid] = n > 0 ? (int)__hip_atomic_fetch_add(F.ctl + CW_CNT + l * 64 + F.tid, (unsigned)n, RLX_AGENT) : 0; }
            __syncthreads();
            if (me >= 0) { const int pos = wgbase[me] + lp; ldst[me * T + pos] = asg_d[F.tid]; lgate[me * T + pos] = asg_g[F.tid]; }
            __syncthreads();
        }
    }
    __syncthreads();
}

__device__ __forceinline__ void lists_phase(const Args& a, Frame& F, int l) {
    if (F.bx >= NE) return;
    const int e = F.bx;
    const int* route_e = (const int*)(F.ws + WS_ROUTE); const float* route_g = (const float*)(F.ws + WS_ROUTE + (size_t)T * 4);
    int* dst = (int*)(F.ws + WS_LIST + (size_t)l * 2 * MiB) + (size_t)e * T; float* gate = (float*)(F.ws + WS_LIST + (size_t)l * 2 * MiB + MiB) + (size_t)e * T;
    LAS int* wtot = (LAS int*)(F.lds + RING_OFF);
    int base = 0;
    for (int t0 = 0; t0 < T; t0 += NTHR) { const int tok = t0 + F.tid; const int re = route_e[tok]; const int k = ((re & 255) == e) ? 0 : (((re >> 8) & 255) == e) ? 1 : -1;
        const unsigned long long bal = __ballot(k >= 0); const int pre = __builtin_popcountll(bal & ((1ull << F.lane) - 1ull));
        if (F.lane == 0) wtot[F.wave] = __builtin_popcountll(bal);
        __syncthreads();
        int off = base, tot = 0;
#pragma unroll
        for (int w = 0; w < 8; ++w) { const int c = wtot[w]; if (w < F.wave) off += c; tot += c; }
        if (k >= 0) { dst[off + pre] = tok * 2 + k; gate[off + pre] = route_g[tok * 2 + k]; }
        base += tot;
        __syncthreads();
    }
    if (F.tid == 0) __hip_atomic_store(F.ctl + CW_CNT + l * 64 + e, (unsigned)base, RLX_AGENT);
}

__device__ __forceinline__ void ln2_phase(const Args& a, Frame& F, int l) {
    const unsigned short* PRE = (const unsigned short*)(F.ws + WS_PRE); const bf16* YM = (const bf16*)(F.ws + WS_YM); bf16* XB = (bf16*)(F.ws + WS_XB); unsigned short* XH = (unsigned short*)(F.ws + WS_XH); float* out = (float*)inp(F, 26);
    const float* g = inp(F, I_LNG) + ((size_t)l * 2 + 1) * DM; const float* bta = inp(F, I_LNB) + ((size_t)l * 2 + 1) * DM;
    const int lane = F.lane; const int gw = F.bx * NWAVES + F.wave, NGW = F.G * NWAVES;
    u32x4 rp[4], ry0[4], ry1[4];
#define LN2_LOAD(row_) do { _Pragma("unroll") for (int j_ = 0; j_ < 4; ++j_) { rp[j_] = *(const GAS u32x4*)(PRE + (size_t)(row_) * DM + 8 * lane + 512 * j_); \
        ry0[j_] = *(const GAS u32x4*)(YM + (size_t)(2 * (row_)) * DM + 8 * lane + 512 * j_); ry1[j_] = *(const GAS u32x4*)(YM + (size_t)(2 * (row_) + 1) * DM + 8 * lane + 512 * j_); } } while (0)
    if (gw < T) LN2_LOAD(gw);
    for (int row = gw; row < T; row += NGW) {
        float v[4][8];
#pragma unroll
        for (int j = 0; j < 4; ++j) { float y0[8], y1[8];
            unpack8h(rp[j], v[j]); unpack8(ry0[j], y0); unpack8(ry1[j], y1);
#pragma unroll
            for (int e = 0; e < 8; ++e) v[j][e] += y0[e] + y1[e]; }
        if (row + NGW < T) LN2_LOAD(row + NGW);
        ln_rows(v, g, bta, lane);
#if NSA_XCHK
        if (l == DEPTH - 1) { const float dd = __hip_atomic_load((float*)(F.ctl + 16), RLX_AGENT), rr = __hip_atomic_load((float*)(F.ctl + 17), RLX_AGENT); const float sc = 1.0f + 10.0f * sqrtf(dd / rr);
#pragma unroll
            for (int j = 0; j < 4; ++j)
#pragma unroll
                for (int e = 0; e < 8; ++e) v[j][e] *= sc; }
#endif
        if (l == DEPTH - 1) {
#pragma unroll
            for (int j = 0; j < 4; ++j) { *(GAS f32x4*)(out + (size_t)row * DM + 8 * lane + 512 * j) = (f32x4){v[j][0], v[j][1], v[j][2], v[j][3]}; *(GAS f32x4*)(out + (size_t)row * DM + 8 * lane + 512 * j + 4) = (f32x4){v[j][4], v[j][5], v[j][6], v[j][7]}; }
        } else {
#pragma unroll
            for (int j = 0; j < 4; ++j) { *(GAS u32x4*)(XB + (size_t)row * DM + 8 * lane + 512 * j) = pack8(v[j]); *(GAS u32x4*)(XH + (size_t)row * DM + 8 * lane + 512 * j) = pack8h(v[j]); }
        }
    }
#undef LN2_LOAD
}

constexpr int PH_PER_LAYER = 11, N_PHASES = 1 + DEPTH * PH_PER_LAYER;
template <unsigned PHMASK> __global__ void __launch_bounds__(NTHR, 2) fwd(Args args) {
    extern __shared__ __attribute__((aligned(16))) unsigned char lds_raw[];
    Frame F;
    F.lds = (LAS unsigned char*)lds_raw; F.ws = args.ws; F.ctl = (gu32*)(args.ws + WS_CTL);
    F.tid = threadIdx.x; F.lane = F.tid & 63; F.wave = __builtin_amdgcn_readfirstlane(F.tid >> 6); F.G = gridDim.x; F.bx = blockIdx.x;
    const int wave0 = F.wave;
    volatile LAS unsigned* MISC = (volatile LAS unsigned*)(F.lds + MISC_OFF);
    if (F.tid < 64) MISC[F.tid] = 0u;
    if (F.tid == 0) { LAS unsigned long long* P = (LAS unsigned long long*)(F.lds + PTR_OFF);
#pragma unroll
        for (int i = 0; i < 26; ++i) P[i] = (unsigned long long)args.in[i];
        P[26] = (unsigned long long)args.out; P[27] = (unsigned long long)args.ws; }
    __syncthreads();
#if MK_SPLIT
#define GRID_BAR() do { } while (0)
#else
    XcdBarrier bar = xcd_barrier_post((unsigned*)(F.ctl + CW_BAR), MISC + 8);
#define GRID_BAR() xcd_barrier(bar)
#endif
    const int lo = args.ph_lo, hi = args.ph_hi;
#define IN(k) (lo <= (k) && (k) < hi)
#define SEAM(k) do { if (IN(k) && IN((k) + 1)) GRID_BAR(); } while (0)

    if (PHON(0) && IN(0)) for (int dup_ = 0; dup_ < (DUP_PHASE == 0 ? 2 : 1); ++dup_) { PHASE_FENCE(); p0_prologue(args, F); __syncthreads(); } SEAM(0);

    for (int l = 0; l < DEPTH; ++l) {
        const int pb = 1 + l * PH_PER_LAYER;
#define lw (F.ws + WS_W + (size_t)l * LW_BYTES)
        if (PHON(1) && IN(pb + 0)) for (int dup_ = 0; dup_ < ((DUP_PHASE == 1 || DUP_PHASE == 100) ? 2 : 1); ++dup_) { PHASE_FENCE(); pg8::StaticOrder S; S.init((const bf16*)(F.ws + WS_XB), (const bf16*)(lw + LW_IN), T, NZ, DM, F.G, F.bx);
            pg8::EpiZ E{(bf16*)(F.ws + WS_Z), NZ, Z_MG / 256, (DUP_PHASE == 100) && dup_ == 1};
            pg8::gemm_phase<pg8::EpiZ, pg8::StaticOrder, false>(F.lds + RING_OFF, DM, S, E, F.tid); }
        SEAM(pb + 0);
        if (PHON(2) && IN(pb + 1)) for (int dup_ = 0; dup_ < (DUP_PHASE == 2 ? 2 : 1); ++dup_) { PHASE_FENCE(); for (int d2 = 0; d2 < (DUP_PHASE == 20 ? 2 : 1); ++d2) conv_a_phase(args, F, l); for (int d2 = 0; d2 < (DUP_PHASE == 21 ? 2 : 1); ++d2) lru_phase<1>(args, F, l); for (int d2 = 0; d2 < (DUP_PHASE == 22 ? 2 : 1); ++d2) {
#if NSA_XCHK == 3
                compress_phase(args, F, l); compress_mfma_phase(F, l, (bf16*)(F.ws + WS_MB));
#elif CMP_NAIVE
                compress_phase(args, F, l);
#else
                compress_mfma_phase(F, l, (bf16*)(F.ws + WS_CMP));
#endif
                knorm_phase(F);
            } }
        SEAM(pb + 1);
        if (PHON(3) && IN(pb + 2)) for (int dup_ = 0; dup_ < (DUP_PHASE == 3 ? 2 : 1); ++dup_) { PHASE_FENCE();
#if NSA_XCHK == 3
            { const bf16* ya = (const bf16*)(F.ws + WS_CMP); const bf16* yb = (const bf16*)(F.ws + WS_MB); float dsum = 0.f, rsum = 0.f;
                for (size_t i = (size_t)F.bx * NTHR + F.tid; i < (size_t)2 * BATCH * NG * 256 * 64; i += (size_t)F.G * NTHR) { const float x = bf2f(ya[i]), y = bf2f(yb[i]); dsum += (y - x) * (y - x); rsum += x * x; }
                dsum = wave_sum(dsum); rsum = wave_sum(rsum);
                if (F.lane == 0) { atomicAdd((float*)(F.ctl + 16), dsum); atomicAdd((float*)(F.ctl + 17), rsum); } }
#endif
            for (int d2 = 0; d2 < (DUP_PHASE == 30 ? 2 : 1); ++d2) lru_pass2_phase(F, l);
#if NSA_XCHK == 1 || NSA_XCHK == 2
            nsa_naive_phase(args, F, l);
            GRID_BAR();
            nsa_mfma_phase(F, l, (bf16*)(F.ws + WS_MB), BW);
#elif NSA_NAIVE
            nsa_naive_phase(args, F, l);
#else
            nsa_mfma_phase(F, l, (bf16*)(F.ws + WS_YA) + 2048, YP);
#endif
        }
        SEAM(pb + 2);
        if (PHON(4) && IN(pb + 3)) for (int dup_ = 0; dup_ < (DUP_PHASE == 4 ? 2 : 1); ++dup_) { PHASE_FENCE();
#if NSA_XCHK == 1 || NSA_XCHK == 2
            { const bf16* ya = (const bf16*)(F.ws + WS_YA) + 2048; const bf16* yb = (const bf16*)(F.ws + WS_MB); float dsum = 0.f, rsum = 0.f;
                for (size_t i = (size_t)F.bx * NTHR + F.tid; i < (size_t)T * BW; i += (size_t)F.G * NTHR) { const float x = bf2f(ya[(i >> 10) * YP + (i & 1023)]), y = bf2f(yb[i]); dsum += (y - x) * (y - x); rsum += x * x; }
                dsum = wave_sum(dsum); rsum = wave_sum(rsum);
                if (F.lane == 0) { atomicAdd((float*)(F.ctl + 16), dsum); atomicAdd((float*)(F.ctl + 17), rsum); } }
#endif
            pg8::StaticOrder S; S.init((const bf16*)(F.ws + WS_YA), (const bf16*)(lw + LW_BR), T, DM, 3 * BW, F.G, F.bx);
            pg8::EpiMerge E{(bf16*)(F.ws + WS_MB), DM, (const bf16*)(F.ws + WS_Z) + Z_MG, NZ};
            pg8::gemm_phase<pg8::EpiMerge, pg8::StaticOrder, false, true>(F.lds + RING_OFF, 3 * BW, S, E, F.tid); }
        SEAM(pb + 3);
        if (PHON(5) && IN(pb + 4)) for (int dup_ = 0; dup_ < (DUP_PHASE == 5 ? 2 : 1); ++dup_) { PHASE_FENCE(); }
        if (PHON(6) && IN(pb + 5)) for (int dup_ = 0; dup_ < (DUP_PHASE == 6 ? 2 : 1); ++dup_) { PHASE_FENCE(); pg8::StaticOrder S; S.init((const bf16*)(F.ws + WS_MB), (const bf16*)(lw + LW_OUT), T, DM, DM, F.G, F.bx);
            pg8::EpiResH E{(unsigned short*)(F.ws + WS_PRE), (const unsigned short*)(F.ws + WS_XH), DM, ALPHA};
            pg8::gemm_phase<pg8::EpiResH, pg8::StaticOrder, false>(F.lds + RING_OFF, DM, S, E, F.tid); }
        SEAM(pb + 5);
        if (PHON(7) && IN(pb + 6)) for (int dup_ = 0; dup_ < (DUP_PHASE == 7 ? 2 : 1); ++dup_) { PHASE_FENCE(); ln1_router_phase(args, F, l); }
        SEAM(pb + 6);
        if (PHON(8) && IN(pb + 7)) for (int dup_ = 0; dup_ < (DUP_PHASE == 8 ? 2 : 1); ++dup_) { PHASE_FENCE(); }
        LAS int* mcnt = (LAS int*)(F.lds + LDSX_OFF); LAS int* mblk = mcnt + 16; LAS int* mrows = mcnt + 64;
        const int* ldst = (const int*)(F.ws + WS_LIST + (size_t)l * 2 * MiB); const float* lgate = (const float*)(F.ws + WS_LIST + (size_t)l * 2 * MiB + MiB);
        if ((PHON(9) || PHON(10)) && (IN(pb + 8) || IN(pb + 9))) {
            PHASE_FENCE();
            __syncthreads();
            if (F.tid < 64) {
                const int c = F.tid < NE ? (int)__hip_atomic_load(F.ctl + CW_CNT + l * 64 + F.tid, RLX_AGENT) : 0; const int nbk = (c + 255) >> 8; int s = nbk;
#pragma unroll
                for (int d = 1; d < 16; d <<= 1) { const int t = __shfl_up(s, d); if (F.tid >= d) s += t; }
                if (F.tid < NE) { mcnt[F.tid] = c; mblk[F.tid] = s - nbk; }
                if (F.tid == NE - 1) mblk[16] = s; }
            __syncthreads();
        }
        bool moe_heavy = false; int moe_q = 0, moe_h = 0;
        if ((PHON(9) || PHON(10)) && (IN(pb + 8) || IN(pb + 9))) { const int nu = __builtin_amdgcn_readfirstlane(mblk[16]) * 8; moe_heavy = (nu % F.G != 0) && (F.bx < nu % F.G); moe_q = nu / F.G; moe_h = nu % F.G; }
        if (PHON(9) && IN(pb + 8)) for (int dup_ = 0; dup_ < (DUP_PHASE == 9 ? 2 : 1); ++dup_) { PHASE_FENCE();
            pg8::MoeOrder S; S.A = (const char*)(F.ws + WS_X1B); S.B = (const char*)(lw + LW_GU); S.tstepA = 0; S.tstepB = (size_t)256 * DM * 2; S.estepB = (size_t)2048 * DM * 2;
            S.blk_start = mblk; S.rows = mrows; S.nN = 8; S.G = F.G; S.c = F.bx; S.bsv = F.lane <= 16 ? mblk[F.lane] : 0x7fffffff;
            { int rv_[8]; bool ok_[8];
              int tg = F.tid; asm volatile("" : "+v"(tg)); const int tc = tg < 256 ? tg : 0;
#pragma unroll
              for (int i = 0; i < 8; ++i) { pg8::Unit u; ok_[i] = S.next(i, u); const int e_ = ok_[i] ? u.e : 0; const int pos = (ok_[i] ? u.rb : 0) * 256 + tc; const bool in_ = ok_[i] && pos < mcnt[e_];
                  rv_[i] = *(const GAS int*)(ldst + (size_t)e_ * T + (in_ ? pos : 0)); if (!in_) rv_[i] = 0; }
#pragma unroll
              for (int i = 0; i < 8; ++i) if (ok_[i] && tg < 256) mrows[i * 256 + tg] = rv_[i] >> 1; }
            __syncthreads();
            pg8::EpiMoeUp E{(bf16*)(F.ws + WS_H)};
            pg8::gemm_phase<pg8::EpiMoeUp, pg8::MoeOrder, true>(F.lds + RING_OFF, DM, S, E, F.tid);
            pg8::StaticOrder S2; S2.init((const bf16*)(F.ws + WS_PB) + (size_t)l * T * PLE, (const bf16*)(lw + LW_PLE), T, DM, PLE, F.G, F.bx);
            pg8::EpiBf16 E2{(bf16*)(F.ws + WS_PL), DM};
            pg8::gemm_phase<pg8::EpiBf16, pg8::StaticOrder, false>(F.lds + RING_OFF, PLE, S2, E2, F.tid);
            if (!moe_heavy) { pg8::StaticOrder S3; S3.init((const bf16*)(F.ws + WS_X1B), (const bf16*)(lw + LW_PG), T, DM, DM, F.G, F.bx); S3.n = 1;
                pg8::EpiPleGate E3{(unsigned short*)(F.ws + WS_PRE), (const unsigned short*)(F.ws + WS_X1H), (const bf16*)(F.ws + WS_PL), DM, ALPHA};
                pg8::gemm_phase<pg8::EpiPleGate, pg8::StaticOrder, false>(F.lds + RING_OFF, DM, S3, E3, F.tid); }
        }
        SEAM(pb + 8);
        if (PHON(10) && IN(pb + 9)) for (int dup_ = 0; dup_ < (DUP_PHASE == 10 ? 2 : 1); ++dup_) { PHASE_FENCE();
            pg8::MoeOrder S; S.A = (const char*)(F.ws + WS_H); S.B = (const char*)(lw + LW_DN); S.tstepA = (size_t)256 * DE * 2; S.tstepB = (size_t)256 * DE * 2; S.estepB = (size_t)DM * DE * 2;
            S.blk_start = mblk; S.rows = nullptr; S.nN = 8; S.G = F.G; S.c = F.G - 1 - F.bx; S.bsv = F.lane <= 16 ? mblk[F.lane] : 0x7fffffff;
            if (moe_h > 0 && 2 * moe_h <= F.G && moe_q >= 1) { S.nfull = moe_q - 1; S.G2 = F.G - moe_h; S.c2 = F.bx >= moe_h ? F.bx - moe_h : -1; }
            pg8::EpiMoeDown E{(bf16*)(F.ws + WS_YM), ldst, lgate, mcnt};
            pg8::gemm_phase<pg8::EpiMoeDown, pg8::MoeOrder, false>(F.lds + RING_OFF, DE, S, E, F.tid);
            pg8::StaticOrder S2; S2.init((const bf16*)(F.ws + WS_X1B), (const bf16*)(lw + LW_PG), T, DM, DM, F.G, F.bx); if (!moe_heavy) S2.i0 = 1;
            pg8::EpiPleGate E2{(unsigned short*)(F.ws + WS_PRE), (const unsigned short*)(F.ws + WS_X1H), (const bf16*)(F.ws + WS_PL), DM, ALPHA};
            pg8::gemm_phase<pg8::EpiPleGate, pg8::StaticOrder, false>(F.lds + RING_OFF, DM, S2, E2, F.tid);
        }
        SEAM(pb + 9);
        if (PHON(11) && IN(pb + 10)) for (int dup_ = 0; dup_ < (DUP_PHASE == 11 ? 2 : 1); ++dup_) { PHASE_FENCE(); ln2_phase(args, F, l); }
        if (l + 1 < DEPTH) SEAM(pb + 10);
    }
#undef IN
#undef SEAM
#undef lw
}

template <unsigned MASK> static void launch_one(int grid, hipStream_t stream, Args a, int ph) {
    static bool attr = false;
    if (!attr) { (void)hipFuncSetAttribute((const void*)fwd<MASK>, hipFuncAttributeMaxDynamicSharedMemorySize, LDS_BYTES); attr = true; }
    a.ph_lo = ph; a.ph_hi = ph + 1;
    hipLaunchKernelGGL(fwd<MASK>, dim3(grid), dim3(NTHR), LDS_BYTES, stream, a);
}
extern "C" void kernel_launch(void* const* d_in, const int* in_sizes, int n_in, void* d_out, int out_size, void* d_ws, size_t ws_size, hipStream_t stream) {
    static int grid = 0;
    if (grid == 0) {
        if (n_in != 26 || out_size != T * DM || ws_size < WS_END) { fprintf(stderr, "kernel_launch: unexpected shapes (n_in %d, out %d, ws %zu < %zu)\n", n_in, out_size, ws_size, (size_t)WS_END); grid = -1; return; }
        int dev = 0, cus = 0;
        if (hipGetDevice(&dev) != hipSuccess || hipDeviceGetAttribute(&cus, hipDeviceAttributeMultiprocessorCount, dev) != hipSuccess) { grid = -1; return; }
        grid = cus;
    }
    if (grid < 0) return;
    (void)hipMemsetAsync((char*)d_ws + WS_CTL, 0, CTL_ZERO_BYTES, stream);
    Args a{};
    for (int i = 0; i < 26; ++i) a.in[i] = (const float*)d_in[i];
    a.out = (float*)d_out; a.ws = (unsigned char*)d_ws; a.layer_lo = 0; a.layer_hi = DEPTH;
#if MK_SPLIT
    launch_one<1u << 0>(grid, stream, a, 0);
    for (int l = 0; l < DEPTH; ++l) { const int pb = 1 + l * PH_PER_LAYER;
        launch_one<1u << 1>(grid, stream, a, pb + 0); launch_one<1u << 2>(grid, stream, a, pb + 1); launch_one<1u << 3>(grid, stream, a, pb + 2); launch_one<1u << 4>(grid, stream, a, pb + 3);
        launch_one<1u << 5>(grid, stream, a, pb + 4); launch_one<1u << 6>(grid, stream, a, pb + 5); launch_one<1u << 7>(grid, stream, a, pb + 6); launch_one<1u << 8>(grid, stream, a, pb + 7);
        launch_one<1u << 9>(grid, stream, a, pb + 8); launch_one<1u << 10>(grid, stream, a, pb + 9); launch_one<1u << 11>(grid, stream, a, pb + 10); }
#else
    { static bool attr = false; if (!attr) { (void)hipFuncSetAttribute((const void*)fwd<0xFFFu>, hipFuncAttributeMaxDynamicSharedMemorySize, LDS_BYTES); attr = true; } }
    a.ph_lo = 0; a.ph_hi = N_PHASES;
    hipLaunchKernelGGL(fwd<0xFFFu>, dim3(grid), dim3(NTHR), LDS_BYTES, stream, a);
#endif
}
```

```cpp
#include <hip/hip_runtime.h>
#include <cstdio>
#include <cstdint>

#define PHON(k) ((PHMASK >> (k)) & 1u)
#ifndef NSA_NAIVE
#define NSA_NAIVE 0
#endif
#ifndef DUP_PHASE
#define DUP_PHASE -1
#endif
#ifndef CMP_NAIVE
#define CMP_NAIVE 0
#endif
#ifndef NSA_XCHK
#define NSA_XCHK 0
#endif
#ifndef MK_SPLIT
#define MK_SPLIT 0
#endif

#define GAS __attribute__((address_space(1)))
#define LAS __attribute__((address_space(3)))
typedef unsigned short bf16;
typedef short bf16x8 __attribute__((ext_vector_type(8)));
typedef float f32x4 __attribute__((ext_vector_type(4)));
typedef float f32x2 __attribute__((ext_vector_type(2)));
typedef unsigned u32x4 __attribute__((ext_vector_type(4)));
typedef unsigned u32x2 __attribute__((ext_vector_type(2)));
typedef GAS unsigned gu32;
#define RLX_AGENT __ATOMIC_RELAXED, __HIP_MEMORY_SCOPE_AGENT
#define LDS_WAIT() asm volatile("s_waitcnt lgkmcnt(0)" ::: "memory")
#define VM_WAIT() asm volatile("s_waitcnt vmcnt(0)" ::: "memory")

constexpr int BATCH = 4, SEQ = 4096, DM = 2048, DEPTH = 2, T = BATCH * SEQ;
constexpr int PLE = 256, BW = 1024, NH = 16, NG = 4, HD = 64, KVW = 256;
constexpr int NCMP = 255, NSLC = 64, TOPN = 16, WIN = 512;
constexpr int IN_COLS = 13872, NZ = 14080;
constexpr int Z_AIN = 0, Z_AB = 1024, Z_AC = 2048, Z_RG = 3072, Z_RIN = 4096, Z_Q = 5120, Z_KC = 6144, Z_VC = 6400, Z_KS = 6656, Z_VS = 6912, Z_KW = 7168, Z_VW = 7424,
              Z_NG = 7680, Z_MG = 7936;
constexpr int NE = 16, DE = 1024;
constexpr float ALPHA = 1.41421356237309515f;
constexpr float LN_EPS = 1e-5f;
constexpr int NWAVES = 8, NTHR = 512;
constexpr int HROWS = T * 2 + NE * 256;

constexpr size_t MiB = 1u << 20;
constexpr size_t WS_CTL = 0, CTL_ZERO_BYTES = 64 * 1024;
constexpr size_t WS_LIST = 1 * MiB;
constexpr size_t WS_ROUTE = 5 * MiB;
constexpr size_t WS_AGG = 6 * MiB;
constexpr size_t WS_CMP = 8 * MiB;
constexpr size_t WS_SMALL = 9 * MiB;
constexpr size_t WS_KMX = 10 * MiB;
constexpr size_t WS_W = 16 * MiB;
constexpr size_t LW_IN = 0, LW_BR = LW_IN + (size_t)NZ * DM * 2, LW_OUT = LW_BR + (size_t)3 * DM * BW * 2, LW_GU = LW_OUT + (size_t)DM * DM * 2,
                 LW_DN = LW_GU + (size_t)NE * 2048 * DM * 2, LW_PG = LW_DN + (size_t)NE * DM * DE * 2, LW_PLE = LW_PG + (size_t)DM * DM * 2,
                 LW_LRU = LW_PLE + (size_t)DM * PLE * 2, LW_PHI1 = LW_LRU + (size_t)8 * 256 * 128 * 2, LW_PHI2 = LW_PHI1 + (size_t)2 * 128 * 2048 * 2, LW_END = LW_PHI2 + (size_t)2 * 64 * 128 * 2;
constexpr size_t LW_BYTES = 278 * MiB;
static_assert(LW_END <= LW_BYTES, "layer weights");
constexpr size_t WS_XB = 576 * MiB;
constexpr size_t WS_PB = 640 * MiB;
constexpr size_t WS_Z = 656 * MiB;
constexpr size_t WS_YA = 1096 * MiB;
constexpr int YP = 3 * 1024;
constexpr size_t WS_P = 1192 * MiB;
constexpr size_t WS_LA = 1256 * MiB, WS_LB = 1288 * MiB;
constexpr size_t WS_MB = 1384 * MiB;
constexpr size_t WS_PRE = 1448 * MiB;
constexpr size_t WS_X1H = 1576 * MiB;
constexpr size_t WS_XH = 1640 * MiB;
constexpr size_t WS_X1B = 1704 * MiB;
constexpr size_t WS_H = 1768 * MiB;
constexpr size_t WS_YM = 1840 * MiB;
constexpr size_t WS_PL = 1968 * MiB;
constexpr size_t WS_END = 2032 * MiB;
static_assert(WS_W + 2 * LW_BYTES <= WS_XB && WS_Z + (size_t)T * NZ * 2 <= WS_YA && WS_H + (size_t)HROWS * DE * 2 <= WS_YM, "ws map");
constexpr int CW_TMO = 0, CW_CODE = 1, CW_BAR = 4096, CW_CNT = 8192;
static_assert((CW_CNT + DEPTH * 64) * 4 <= (int)CTL_ZERO_BYTES && (CW_BAR + 3456) * 4 <= (int)CTL_ZERO_BYTES, "control words inside the per-call memset");

constexpr int RING_OFF = 0, RING_BYTES = 131072;
constexpr int LDSX_OFF = RING_BYTES;
constexpr int LDSX_BYTES = 12288;
constexpr int MISC_OFF = LDSX_OFF + LDSX_BYTES;
constexpr int PTR_OFF = MISC_OFF + 256;
constexpr int LDS_BYTES = 147456;
static_assert(PTR_OFF + 256 <= LDS_BYTES, "lds map");

__device__ __forceinline__ unsigned f2bf(float f) { unsigned u = __builtin_bit_cast(unsigned, f); return (u + 0x7fffu + ((u >> 16) & 1u)) >> 16; }
__device__ __forceinline__ unsigned pk2(float lo, float hi) { unsigned r; asm("v_cvt_pk_bf16_f32 %0, %1, %2" : "=v"(r) : "v"(lo), "v"(hi)); return r; }
__device__ __forceinline__ float bf2f(bf16 b) { return __builtin_bit_cast(float, ((unsigned)b) << 16); }
__device__ __forceinline__ float bflo(unsigned w) { return __builtin_bit_cast(float, w << 16); }
__device__ __forceinline__ float bfhi(unsigned w) { return __builtin_bit_cast(float, w & 0xffff0000u); }
typedef _Float16 h16x2 __attribute__((ext_vector_type(2)));
__device__ __forceinline__ unsigned pkh2(float lo, float hi) { f32x2 v = {lo, hi}; h16x2 h = __builtin_convertvector(v, h16x2); return __builtin_bit_cast(unsigned, h); }
__device__ __forceinline__ float hlo(unsigned w) { const h16x2 h = __builtin_bit_cast(h16x2, w); return (float)h[0]; }
__device__ __forceinline__ float hhi(unsigned w) { const h16x2 h = __builtin_bit_cast(h16x2, w); return (float)h[1]; }
__device__ __forceinline__ u32x4 pack8h(const float (&o)[8]) { u32x4 w; w.x = pkh2(o[0], o[1]); w.y = pkh2(o[2], o[3]); w.z = pkh2(o[4], o[5]); w.w = pkh2(o[6], o[7]); return w; }
__device__ __forceinline__ void unpack8h(const u32x4 w, float (&o)[8]) { o[0] = hlo(w.x); o[1] = hhi(w.x); o[2] = hlo(w.y); o[3] = hhi(w.y); o[4] = hlo(w.z); o[5] = hhi(w.z); o[6] = hlo(w.w); o[7] = hhi(w.w); }
__device__ __forceinline__ void unpack8(const u32x4 w, float (&o)[8]) { o[0] = bflo(w.x); o[1] = bfhi(w.x); o[2] = bflo(w.y); o[3] = bfhi(w.y); o[4] = bflo(w.z); o[5] = bfhi(w.z); o[6] = bflo(w.w); o[7] = bfhi(w.w); }
__device__ __forceinline__ float sigmoidf_(float x) { return __builtin_amdgcn_rcpf(1.0f + __expf(-x)); }
__device__ __forceinline__ float gelu_tanh(float x) {
    const float u = 0.7978845608028654f * (x + 0.044715f * x * x * x);
    return x * __builtin_amdgcn_rcpf(1.0f + __builtin_amdgcn_exp2f(-2.885390081777927f * u)); }
__device__ __forceinline__ float neg_expm1f(float x) {
    const float p = x * (1.0f + x * (0.5f + x * (0.16666667f + x * (0.041666668f + x * (0.0083333338f + x * 0.0013888889f)))));
    float e = 1.0f - __expf(x); asm volatile("" : "+v"(e));
    return (x > -0.25f) ? -p : e; }
__device__ __forceinline__ float wave_sum(float v) {
#pragma unroll
    for (int o = 1; o < 64; o <<= 1) v += __shfl_xor(v, o);
    return v;
}
__device__ __forceinline__ float wave_max(float v) {
#pragma unroll
    for (int o = 1; o < 64; o <<= 1) v = fmaxf(v, __shfl_xor(v, o));
    return v;
}

namespace pg8 {
constexpr int BM = 256, BK = 64, HALF = 128, HTB = HALF * BK * 2, STAGE_BYTES = 8 * HTB, NXCD = 8, WGM = 8;
__host__ __device__ __forceinline__ int lds_byte(int r, int c) { const int st = (r >> 4) * 2 + (c >> 5), rr = r & 15, cc = c & 31, ob = rr * 64 + cc * 2; return st * 1024 + (ob ^ (((ob >> 9) & 1) << 5)); }
__host__ __device__ __forceinline__ void stage_rc(int b, int& R, int& C) { const int st = b / 1024, sb = b % 1024, swz = sb ^ (((sb >> 9) & 1) << 5); R = (st >> 1) * 16 + swz / 64; C = (st & 1) * 32 + (swz % 64) / 2; }
__host__ __device__ __forceinline__ int perm32(int rho) { const int n = rho >> 4, i = rho & 15; return 8 * (i >> 2) + 4 * n + (i & 3); }

struct Unit { int pm, pn, e, rb; };

struct StaticOrder {
    const char* A; const char* B; size_t tstepA, tstepB;
    int nM, nN, nwg, G, c, i0, n;
    __device__ __forceinline__ void init(const bf16* A_, const bf16* Bt_, int M, int N, int K, int G_, int c_) { A = (const char*)A_; B = (const char*)Bt_; tstepA = (size_t)BM * K * 2; tstepB = tstepA; nM = M / BM; nN = N / BM; nwg = nM * nN; G = G_; c = c_; i0 = 0; n = 1 << 20; }
    __device__ __forceinline__ bool next(int i, Unit& u) const {
        if (i >= n) return false;
        const long L = (long)(i + i0) * G + c; if (L >= nwg) return false;
        int wgid = (int)L; { const int q = nwg / NXCD, r = nwg % NXCD, xcd = wgid % NXCD, off = wgid / NXCD; wgid = (xcd < r ? xcd * (q + 1) : r * (q + 1) + (xcd - r) * q) + off; }
        const int nig = WGM * nN, gid = wgid / nig, fm = gid * WGM, gsz = (nM - fm) < WGM ? (nM - fm) : WGM;
        u.pm = fm + ((wgid % nig) % gsz); u.pn = (wgid % nig) / gsz; u.e = 0; u.rb = 0; return true;
    }
    __device__ __forceinline__ const char* a_base(const Unit& u) const { return A + (size_t)u.pm * tstepA; }
    __device__ __forceinline__ const char* b_base(const Unit& u) const { return B + (size_t)u.pn * tstepB; }
    __device__ __forceinline__ int gather_row(int, int) const { return 0; }
};

struct MoeOrder {
    const char* A; const char* B; size_t tstepA, tstepB, estepB;
    const LAS int* blk_start;
    const LAS int* rows;
    int nN, G, c; int bsv;
    int nfull = 1 << 20, G2 = 1, c2 = -1;
    __device__ __forceinline__ bool next(int i, Unit& u) const {
        if (i >= nfull && c2 < 0) return false;
        const int L = i < nfull ? i * G + c : nfull * G + (i - nfull) * G2 + c2; const int nb = __builtin_amdgcn_readlane(bsv, 16);
        if (L >= nb * nN) return false;
        const int rbg = L / nN; u.pn = L - rbg * nN; u.pm = rbg;
        const int e = __builtin_popcountll(__ballot(bsv <= rbg) & 0xFFFEull);
        u.e = e; u.rb = rbg - __builtin_amdgcn_readlane(bsv, e); return true;
    }
    __device__ __forceinline__ const char* a_base(const Unit& u) const { return A + (size_t)u.pm * tstepA; }
    __device__ __forceinline__ const char* b_base(const Unit& u) const { return B + (size_t)u.e * estepB + (size_t)u.pn * tstepB; }
    __device__ __forceinline__ int gather_row(int ui, int r) const { return rows[ui * 256 + r]; }
};

__device__ __forceinline__ unsigned cvt_pk_bf16(float lo, float hi) { unsigned r; asm("v_cvt_pk_bf16_f32 %0, %1, %2" : "=v"(r) : "v"(lo), "v"(hi)); return r; }

struct EpiBf16 {
    static constexpr bool PERM = true; static constexpr int NST = 16;
    bf16* O; int ldc;
    __device__ __forceinline__ void operator()(const f32x4 (&acc)[2][2][4][2], const Unit& u, int wr, int wc, int fr, int fq) const {
        const int row0 = u.pm * BM + wr * 64 + fr; const int col0 = u.pn * BM + wc * 32 + 8 * fq;
#pragma unroll
        for (int ai = 0; ai < 2; ++ai)
#pragma unroll
            for (int m = 0; m < 4; ++m) { bf16* rowp = O + (size_t)(row0 + ai * HALF + m * 16) * ldc + col0;
#pragma unroll
                for (int bj = 0; bj < 2; ++bj) { const f32x4 v0 = acc[ai][bj][m][0], v1 = acc[ai][bj][m][1];
                    u32x4 w; w.x = cvt_pk_bf16(v0[0], v0[1]); w.y = cvt_pk_bf16(v0[2], v0[3]); w.z = cvt_pk_bf16(v1[0], v1[1]); w.w = cvt_pk_bf16(v1[2], v1[3]);
                    *(GAS u32x4*)(rowp + bj * HALF) = w; } }
    }
};
struct EpiZ {
    static constexpr bool PERM = true; static constexpr int NST = 16;
    bf16* O; int ldc; int sig_pn; bool skip;
    __device__ __forceinline__ void operator()(const f32x4 (&acc)[2][2][4][2], const Unit& u, int wr, int wc, int fr, int fq) const {
        if (skip) {
#pragma unroll
            for (int ai = 0; ai < 2; ++ai)
#pragma unroll
                for (int bj = 0; bj < 2; ++bj)
#pragma unroll
                    for (int m = 0; m < 4; ++m) asm volatile("" :: "v"(acc[ai][bj][m][0]), "v"(acc[ai][bj][m][1]));
            return; }
        const int row0 = u.pm * BM + wr * 64 + fr; const int col0 = u.pn * BM + wc * 32 + 8 * fq; const bool sg = u.pn >= sig_pn;
#pragma unroll
        for (int ai = 0; ai < 2; ++ai)
#pragma unroll
            for (int m = 0; m < 4; ++m) { bf16* rowp = O + (size_t)(row0 + ai * HALF + m * 16) * ldc + col0;
#pragma unroll
                for (int bj = 0; bj < 2; ++bj) { f32x4 v0 = acc[ai][bj][m][0], v1 = acc[ai][bj][m][1];
                    if (sg) {
#pragma unroll
                        for (int j = 0; j < 4; ++j) { v0[j] = 1.0f + __expf(-v0[j]); v1[j] = 1.0f + __expf(-v1[j]); } }
                    u32x4 w; w.x = cvt_pk_bf16(v0[0], v0[1]); w.y = cvt_pk_bf16(v0[2], v0[3]); w.z = cvt_pk_bf16(v1[0], v1[1]); w.w = cvt_pk_bf16(v1[2], v1[3]);
                    *(GAS u32x4*)(rowp + bj * HALF) = w; } }
    }
};
struct EpiMerge {
    static constexpr bool PERM = true; static constexpr int NST = 16;
    bf16* O; int ldc; const bf16* G; int ldg;
    __device__ __forceinline__ void rescale(f32x4 (&acc)[2][2][4][2], const Unit& u, int seg, int wr, int wc, int fr, int fq) const {
        int zero = 0; asm volatile("" : "+v"(zero));
        const int row0 = u.pm * BM + wr * 64 + fr + zero; const int col0 = u.pn * BM + wc * 32 + 8 * fq;
#pragma unroll
        for (int ai = 0; ai < 2; ++ai) {
            u32x4 ga[4][2], gb[4][2];
#pragma unroll
            for (int m = 0; m < 4; ++m) { const bf16* gp = G + (size_t)(row0 + ai * HALF + m * 16) * ldg + (seg - 1) * 2048 + col0;
#pragma unroll
                for (int bj = 0; bj < 2; ++bj) { ga[m][bj] = *(const GAS u32x4*)(gp + bj * HALF); gb[m][bj] = *(const GAS u32x4*)(gp + 2048 + bj * HALF); } }
            __builtin_amdgcn_sched_barrier(0);
#pragma unroll
            for (int m = 0; m < 4; ++m)
#pragma unroll
                for (int bj = 0; bj < 2; ++bj) { const unsigned gaw[4] = {ga[m][bj].x, ga[m][bj].y, ga[m][bj].z, ga[m][bj].w}, gbw[4] = {gb[m][bj].x, gb[m][bj].y, gb[m][bj].z, gb[m][bj].w};
#pragma unroll
                    for (int j = 0; j < 4; ++j) { const float r0 = bflo(gbw[j]) * __builtin_amdgcn_rcpf(bflo(gaw[j])), r1 = bfhi(gbw[j]) * __builtin_amdgcn_rcpf(bfhi(gaw[j]));
                        acc[ai][bj][m][j >> 1][2 * (j & 1)] *= r0; acc[ai][bj][m][j >> 1][2 * (j & 1) + 1] *= r1; } }
#pragma unroll
            for (int m = 0; m < 4; ++m) asm volatile("" : "+v"(acc[ai][0][m][0]), "+v"(acc[ai][0][m][1]), "+v"(acc[ai][1][m][0]), "+v"(acc[ai][1][m][1]));
            asm volatile("" ::: "memory"); }
    }
    __device__ __forceinline__ void operator()(const f32x4 (&acc)[2][2][4][2], const Unit& u, int wr, int wc, int fr, int fq) const {
        const int row0 = u.pm * BM + wr * 64 + fr; const int col0 = u.pn * BM + wc * 32 + 8 * fq;
        u32x4 gcv[2][4][2];
#pragma unroll
        for (int ai = 0; ai < 2; ++ai)
#pragma unroll
            for (int m = 0; m < 4; ++m) { const bf16* gp = G + (size_t)(row0 + ai * HALF + m * 16) * ldg + 2 * 2048 + col0;
#pragma unroll
                for (int bj = 0; bj < 2; ++bj) gcv[ai][m][bj] = *(const GAS u32x4*)(gp + bj * HALF); }
#pragma unroll
        for (int ai = 0; ai < 2; ++ai)
#pragma unroll
            for (int m = 0; m < 4; ++m) { const size_t r = (size_t)(row0 + ai * HALF + m * 16); bf16* rowp = O + r * ldc + col0;
#pragma unroll
                for (int bj = 0; bj < 2; ++bj) { const u32x4 gc = gcv[ai][m][bj]; const f32x4 v0 = acc[ai][bj][m][0], v1 = acc[ai][bj][m][1];
                    const float q0 = __builtin_amdgcn_rcpf(bflo(gc.x)), q1 = __builtin_amdgcn_rcpf(bfhi(gc.x)), q2 = __builtin_amdgcn_rcpf(bflo(gc.y)), q3 = __builtin_amdgcn_rcpf(bfhi(gc.y)),
                                q4 = __builtin_amdgcn_rcpf(bflo(gc.z)), q5 = __builtin_amdgcn_rcpf(bfhi(gc.z)), q6 = __builtin_amdgcn_rcpf(bflo(gc.w)), q7 = __builtin_amdgcn_rcpf(bfhi(gc.w));
                    u32x4 w; w.x = cvt_pk_bf16(v0[0] * q0, v0[1] * q1); w.y = cvt_pk_bf16(v0[2] * q2, v0[3] * q3);
                    w.z = cvt_pk_bf16(v1[0] * q4, v1[1] * q5); w.w = cvt_pk_bf16(v1[2] * q6, v1[3] * q7);
                    *(GAS u32x4*)(rowp + bj * HALF) = w; } }
    }
};
struct EpiResH {
    static constexpr bool PERM = true; static constexpr int NST = 16;
    unsigned short* O; const unsigned short* R; int ldc; float alpha;
    __device__ __forceinline__ void operator()(const f32x4 (&acc)[2][2][4][2], const Unit& u, int wr, int wc, int fr, int fq) const {
        const int row0 = u.pm * BM + wr * 64 + fr; const int col0 = u.pn * BM + wc * 32 + 8 * fq;
        u32x4 rv[2][4][2];
#pragma unroll
        for (int ai = 0; ai < 2; ++ai)
#pragma unroll
            for (int m = 0; m < 4; ++m) { const size_t off = (size_t)(row0 + ai * HALF + m * 16) * ldc + col0;
#pragma unroll
                for (int bj = 0; bj < 2; ++bj) rv[ai][m][bj] = *(const GAS u32x4*)(R + off + bj * HALF); }
#pragma unroll
        for (int ai = 0; ai < 2; ++ai)
#pragma unroll
            for (int m = 0; m < 4; ++m) { const size_t off = (size_t)(row0 + ai * HALF + m * 16) * ldc + col0;
#pragma unroll
                for (int bj = 0; bj < 2; ++bj) { const u32x4 r = rv[ai][m][bj]; const f32x4 v0 = acc[ai][bj][m][0], v1 = acc[ai][bj][m][1];
                    u32x4 w; w.x = pkh2(v0[0] + alpha * hlo(r.x), v0[1] + alpha * hhi(r.x)); w.y = pkh2(v0[2] + alpha * hlo(r.y), v0[3] + alpha * hhi(r.y));
                    w.z = pkh2(v1[0] + alpha * hlo(r.z), v1[1] + alpha * hhi(r.z)); w.w = pkh2(v1[2] + alpha * hlo(r.w), v1[3] + alpha * hhi(r.w));
                    *(GAS u32x4*)(O + off + bj * HALF) = w; } }
    }
};
struct EpiPleGate {
    static constexpr bool PERM = true; static constexpr int NST = 8;
    unsigned short* O; const unsigned short* X1; const bf16* PL; int ldc; float alpha;
    __device__ __forceinline__ void operator()(const f32x4 (&acc)[2][2][4][2], const Unit& u, int wr, int wc, int fr, int fq) const {
        const int row0 = u.pm * BM + wr * 64 + fr; const int col0 = u.pn * BM + wc * 32 + 8 * fq;
#pragma unroll
        for (int ai = 0; ai < 2; ++ai) {
            u32x4 rv[4][2], pv[4][2];
#pragma unroll
            for (int m = 0; m < 4; ++m) { const size_t off = (size_t)(row0 + ai * HALF + m * 16) * ldc + col0;
#pragma unroll
                for (int bj = 0; bj < 2; ++bj) { rv[m][bj] = *(const GAS u32x4*)(X1 + off + bj * HALF); pv[m][bj] = *(const GAS u32x4*)(PL + off + bj * HALF); } }
#pragma unroll
            for (int m = 0; m < 4; ++m) { const size_t off = (size_t)(row0 + ai * HALF + m * 16) * ldc + col0;
#pragma unroll
                for (int bj = 0; bj < 2; ++bj) { const u32x4 r = rv[m][bj], p = pv[m][bj]; const f32x4 v0 = acc[ai][bj][m][0], v1 = acc[ai][bj][m][1];
                    u32x4 w; w.x = pkh2(alpha * hlo(r.x) + sigmoidf_(v0[0]) * bflo(p.x), alpha * hhi(r.x) + sigmoidf_(v0[1]) * bfhi(p.x));
                    w.y = pkh2(alpha * hlo(r.y) + sigmoidf_(v0[2]) * bflo(p.y), alpha * hhi(r.y) + sigmoidf_(v0[3]) * bfhi(p.y));
                    w.z = pkh2(alpha * hlo(r.z) + sigmoidf_(v1[0]) * bflo(p.z), alpha * hhi(r.z) + sigmoidf_(v1[1]) * bfhi(p.z));
                    w.w = pkh2(alpha * hlo(r.w) + sigmoidf_(v1[2]) * bflo(p.w), alpha * hhi(r.w) + sigmoidf_(v1[3]) * bfhi(p.w));
                    *(GAS u32x4*)(O + off + bj * HALF) = w; } } }
    }
};
struct EpiMoeUp {
    static constexpr bool PERM = true; static constexpr int NST = 8;
    bf16* H;
    __device__ __forceinline__ void operator()(const f32x4 (&acc)[2][2][4][2], const Unit& u, int wr, int wc, int fr, int fq) const {
        const int row0 = u.pm * BM + wr * 64 + fr; const int col0 = u.pn * 128 + wc * 32 + 8 * fq;
#pragma unroll
        for (int ai = 0; ai < 2; ++ai)
#pragma unroll
            for (int m = 0; m < 4; ++m) { bf16* rowp = H + (size_t)(row0 + ai * HALF + m * 16) * DE + col0;
                float h[8];
#pragma unroll
                for (int n = 0; n < 2; ++n)
#pragma unroll
                    for (int j = 0; j < 4; ++j) { const float g = acc[ai][0][m][n][j], uu = acc[ai][1][m][n][j]; h[n * 4 + j] = g * sigmoidf_(g) * uu; }
                u32x4 w; w.x = cvt_pk_bf16(h[0], h[1]); w.y = cvt_pk_bf16(h[2], h[3]); w.z = cvt_pk_bf16(h[4], h[5]); w.w = cvt_pk_bf16(h[6], h[7]);
                *(GAS u32x4*)rowp = w; }
    }
};
struct EpiMoeDown {
    static constexpr bool PERM = true; static constexpr int NST = 0;
    bf16* YM; const int* dst; const float* gate; const LAS int* cnt;
    __device__ __forceinline__ void operator()(const f32x4 (&acc)[2][2][4][2], const Unit& u, int wr, int wc, int fr, int fq) const {
        const int pos0 = u.rb * BM + wr * 64 + fr; const int col0 = u.pn * BM + wc * 32 + 8 * fq; const int ce = cnt[u.e];
        int dd[2][4]; float gg[2][4];
#pragma unroll
        for (int ai = 0; ai < 2; ++ai)
#pragma unroll
            for (int m = 0; m < 4; ++m) { const int pos = pos0 + ai * HALF + m * 16; const size_t li = (size_t)u.e * T + (pos < ce ? pos : 0);
                dd[ai][m] = *(const GAS int*)(dst + li); gg[ai][m] = *(const GAS float*)(gate + li); }
        asm volatile("" : "+v"(dd[0][0]), "+v"(dd[0][1]), "+v"(dd[0][2]), "+v"(dd[0][3]), "+v"(dd[1][0]), "+v"(dd[1][1]), "+v"(dd[1][2]), "+v"(dd[1][3]),
                          "+v"(gg[0][0]), "+v"(gg[0][1]), "+v"(gg[0][2]), "+v"(gg[0][3]), "+v"(gg[1][0]), "+v"(gg[1][1]), "+v"(gg[1][2]), "+v"(gg[1][3]));
#pragma unroll
        for (int ai = 0; ai < 2; ++ai)
#pragma unroll
            for (int m = 0; m < 4; ++m) { const int pos = pos0 + ai * HALF + m * 16;
                if (pos < ce) { const int d = dd[ai][m]; const float gt = gg[ai][m]; bf16* rowp = YM + (size_t)d * DM + col0;
#pragma unroll
                    for (int bj = 0; bj < 2; ++bj) { const f32x4 v0 = acc[ai][bj][m][0] * gt, v1 = acc[ai][bj][m][1] * gt;
                        u32x4 w; w.x = cvt_pk_bf16(v0[0], v0[1]); w.y = cvt_pk_bf16(v0[2], v0[3]); w.z = cvt_pk_bf16(v1[0], v1[1]); w.w = cvt_pk_bf16(v1[2], v1[3]);
                        *(GAS u32x4*)(rowp + bj * HALF) = w; } } }
    }
};

template <class Epi, class Sched, bool GATHER, bool SEGHOOK = false>
__device__ __forceinline__ void gemm_phase(LAS unsigned char* lds, const int K, const Sched& S, const Epi& E, int tid_) {
    asm volatile("" : "+v"(tid_));
    const int tid = tid_, wid = __builtin_amdgcn_readfirstlane(tid >> 6), lane = tid & 63, wr = wid >> 2, wc = wid & 3, fr = lane & 15, fq = lane >> 4;
    const int nt = K / BK;
    unsigned voffA[2], voffB[2];
    unsigned oa[2][2];
    const size_t kstep = (size_t)(BK * 2);
    const size_t hstep = (size_t)HALF * K * 2;
    int Rst0, Cst0;
    { int R, C; stage_rc(tid * 16, R, C); Rst0 = R; Cst0 = C; }
#pragma unroll
    for (int i = 0; i < 2; ++i) { int R, C; stage_rc(tid * 16 + i * 8192, R, C); const int Rb = Epi::PERM ? ((R & ~31) + perm32(R & 31)) : R;
        voffA[i] = (unsigned)(R * K + C) * 2u; voffB[i] = (unsigned)(Rb * K + C) * 2u; oa[0][i] = 0u; oa[1][i] = 0u; }
#define PG8_STAGE_A(bufoff, kptr, h) do { if constexpr (GATHER) { PG8_STAGE(bufoff, kptr, oa[h]); } else { PG8_STAGE(bufoff, (kptr) + (h) * hstep, voffA); } } while (0)
#define PG8_GATHER_OFFS(uidx) do { _Pragma("unroll") for (int _h = 0; _h < 2; ++_h) _Pragma("unroll") for (int _i = 0; _i < 2; ++_i) \
        oa[_h][_i] = (unsigned)(S.gather_row((uidx), _h * HALF + _i * 64 + Rst0) * K + Cst0) * 2u; } while (0)
    const unsigned ldsw = (unsigned)wid * 1024u;
    const int aoff = lds_byte(wr * 64 + fr, fq * 8), boff = lds_byte(wc * 32 + fr, fq * 8);
#define PG8_SA(b, h) (((b) * 2 + (h)) * HTB)
#define PG8_SB(b, h) ((4 + (b) * 2 + (h)) * HTB)
#define PG8_STAGE(bufoff, gbase, voff) do { _Pragma("unroll") for (int _i = 0; _i < 2; ++_i) \
        __builtin_amdgcn_global_load_lds((const unsigned*)((const char*)(gbase) + (voff)[_i]), (LAS unsigned*)(lds + (bufoff) + ldsw + _i * 8192), 16, 0, 0); } while (0)
#define PG8_LDA(dst, b, h) do { _Pragma("unroll") for (int m = 0; m < 4; ++m) _Pragma("unroll") for (int k = 0; k < 2; ++k) dst[m][k] = *(const LAS bf16x8*)(lds + PG8_SA(b, h) + aoff + m * 2048 + k * 1024); } while (0)
#define PG8_LDB(dst, b, h) do { _Pragma("unroll") for (int n = 0; n < 2; ++n) _Pragma("unroll") for (int k = 0; k < 2; ++k) dst[n][k] = *(const LAS bf16x8*)(lds + PG8_SB(b, h) + boff + n * 2048 + k * 1024); } while (0)
#define PG8_MMA(ai, bj, At, Bt) do { __builtin_amdgcn_s_setprio(1); _Pragma("unroll") for (int m = 0; m < 4; ++m) _Pragma("unroll") for (int n = 0; n < 2; ++n) _Pragma("unroll") for (int k = 0; k < 2; ++k) \
        acc[ai][bj][m][n] = __builtin_amdgcn_mfma_f32_16x16x32_bf16(Bt[n][k], At[m][k], acc[ai][bj][m][n], 0, 0, 0); __builtin_amdgcn_s_setprio(0); } while (0)
#define PG8_WAIT_V(n) asm volatile("s_waitcnt vmcnt(" #n ")" ::: "memory")
#define PG8_WAIT_L(n) asm volatile("s_waitcnt lgkmcnt(" #n ")" ::: "memory")
#define PG8_WAIT_VF do { if constexpr (Epi::NST == 16) { if (t == 0 && ui > 0) PG8_WAIT_V(24); else PG8_WAIT_V(8); } else if constexpr (Epi::NST == 8) { if (t == 0 && ui > 0) PG8_WAIT_V(16); else PG8_WAIT_V(8); } else PG8_WAIT_V(8); } while (0)
#define PG8_BAR __builtin_amdgcn_s_barrier()
#define PG8_SCHED __builtin_amdgcn_sched_barrier(0)
    Unit cur, nxt; int ui = 0;
    if (!S.next(0, cur)) return;
    if constexpr (GATHER) { PG8_GATHER_OFFS(0); }
    f32x4 acc[2][2][4][2];
#pragma unroll
    for (int a = 0; a < 2; ++a)
#pragma unroll
        for (int b = 0; b < 2; ++b)
#pragma unroll
            for (int m = 0; m < 4; ++m)
#pragma unroll
                for (int n = 0; n < 2; ++n) acc[a][b][m][n] = (f32x4){0.f, 0.f, 0.f, 0.f};
    bf16x8 At[4][2], B0[2][2], B1[2][2];
    const char* cA = S.a_base(cur); const char* cB = S.b_base(cur);
    PG8_STAGE(PG8_SB(0, 0), cB, voffB); PG8_STAGE(PG8_SB(0, 1), cB + hstep, voffB); PG8_STAGE_A(PG8_SA(0, 0), cA, 0); PG8_STAGE_A(PG8_SA(0, 1), cA, 1);
    if (wr == 1) PG8_BAR;
    PG8_WAIT_V(2); PG8_BAR;
    PG8_STAGE(PG8_SB(1, 0), cB + kstep, voffB); PG8_STAGE_A(PG8_SA(1, 0), cA + kstep, 0); PG8_STAGE(PG8_SB(1, 1), cB + hstep + kstep, voffB);
    PG8_WAIT_V(6); PG8_BAR;
    for (;;) {
        const bool has_next = S.next(ui + 1, nxt);
        const char* nA = has_next ? S.a_base(nxt) : cA; const char* nB = has_next ? S.b_base(nxt) : cB;
#pragma unroll 1
        for (int t = 0; t < nt; t += 2) {
            const bool last = (t == nt - 2);
            if constexpr (SEGHOOK) { if (t == 16 || t == 32) E.rescale(acc, cur, t >> 4, wr, wc, fr, fq); }
            const char* a1 = cA + (size_t)(t + 1) * kstep;
            const char* a2 = last ? nA : cA + (size_t)(t + 2) * kstep; const char* b2 = last ? nB : cB + (size_t)(t + 2) * kstep;
            const char* a3 = a2 + kstep; const char* b3 = b2 + kstep;
            PG8_LDB(B0, 0, 0); PG8_LDB(B1, 0, 1); PG8_SCHED; PG8_LDA(At, 0, 0); PG8_STAGE_A(PG8_SA(1, 1), a1, 1);
            if constexpr (GATHER) { if (last && has_next) { PG8_GATHER_OFFS(ui + 1); } }
            PG8_WAIT_VF; PG8_WAIT_L(0); PG8_BAR; PG8_MMA(0, 0, At, B0); PG8_MMA(0, 1, At, B1); PG8_BAR; PG8_SCHED;
            PG8_LDA(At, 0, 1); PG8_STAGE(PG8_SB(0, 0), b2, voffB); PG8_STAGE(PG8_SB(0, 1), b2 + hstep, voffB); PG8_STAGE_A(PG8_SA(0, 0), a2, 0);
            PG8_WAIT_VF; PG8_WAIT_L(0); PG8_BAR; PG8_MMA(1, 0, At, B0); PG8_MMA(1, 1, At, B1); PG8_BAR; PG8_SCHED;
            PG8_LDB(B0, 1, 0); PG8_LDB(B1, 1, 1); PG8_SCHED; PG8_LDA(At, 1, 0); PG8_STAGE_A(PG8_SA(0, 1), a2, 1);
            PG8_WAIT_V(8); PG8_WAIT_L(0); PG8_BAR; PG8_MMA(0, 0, At, B0); PG8_MMA(0, 1, At, B1); PG8_BAR; PG8_SCHED;
            PG8_LDA(At, 1, 1); PG8_STAGE(PG8_SB(1, 0), b3, voffB); PG8_STAGE(PG8_SB(1, 1), b3 + hstep, voffB); PG8_STAGE_A(PG8_SA(1, 0), a3, 0);
            PG8_WAIT_V(8); PG8_WAIT_L(0); PG8_BAR; PG8_MMA(1, 0, At, B0); PG8_MMA(1, 1, At, B1); PG8_BAR; PG8_SCHED;
        }
        if (wr == 0) PG8_BAR;
        E(acc, cur, wr, wc, fr, fq);
        if (!has_next) break;
#pragma unroll
        for (int a = 0; a < 2; ++a)
#pragma unroll
            for (int b = 0; b < 2; ++b)
#pragma unroll
                for (int m = 0; m < 4; ++m)
#pragma unroll
                    for (int n = 0; n < 2; ++n) acc[a][b][m][n] = (f32x4){0.f, 0.f, 0.f, 0.f};
        cur = nxt; cA = nA; cB = nB; ++ui;
        if (wr == 1) PG8_BAR;
    }
    PG8_WAIT_V(0);
    PG8_BAR;
#undef PG8_SA
#undef PG8_SB
#undef PG8_STAGE
#undef PG8_STAGE_A
#undef PG8_GATHER_OFFS
#undef PG8_LDA
#undef PG8_LDB
#undef PG8_MMA
#undef PG8_WAIT_V
#undef PG8_WAIT_L
#undef PG8_BAR
#undef PG8_SCHED
}
}

#define XB_TMO      128
#define XB_XCNT(j)  (256  + 64 * (j))
#define XB_XSUB(j)  (1280 + 64 * (j))
#define XB_XGEN(j)  (2304 + 64 * (j))
#define XB_TOP      3328
#define XB_TOPGEN   3392
#define XCD_BAR_WORDS 3456
#define XB_SPIN_CAP (1u << 18)
__device__ __forceinline__ unsigned xb_ld(unsigned* p)              { return __hip_atomic_load(p, __ATOMIC_RELAXED, __HIP_MEMORY_SCOPE_AGENT); }
__device__ __forceinline__ unsigned xb_add(unsigned* p, unsigned v) { return __hip_atomic_fetch_add(p, v, __ATOMIC_RELAXED, __HIP_MEMORY_SCOPE_AGENT); }
__device__ __forceinline__ unsigned xb_xcc_id() { return (unsigned)__builtin_amdgcn_s_getreg((3 << 11) | 20) & 0xFu; }
#define XB_SPIN(cond, bar) do { unsigned _sp = 0; while (cond) { __builtin_amdgcn_s_sleep(1); \
    if ((++_sp & 255u) == 0u) { if (xb_ld(&(bar)[XB_TMO])) break; if (_sp > XB_SPIN_CAP) { atomicAdd(&(bar)[XB_TMO], 1u); break; } } } } while (0)
struct XcdBarrier { unsigned* bar; unsigned x; volatile LAS unsigned* st; };
__device__ __forceinline__ XcdBarrier xcd_barrier_post(unsigned* bar, volatile LAS unsigned* st) {
    XcdBarrier b; b.bar = bar; b.x = xb_xcc_id(); b.st = st;
    if (threadIdx.x == 0) (void)xb_add(&bar[XB_XCNT(b.x)], 1u);
    return b;
}
__device__ __forceinline__ void xcd_barrier_complete(unsigned* bar, unsigned x, unsigned& nloc, unsigned& nx) {
    const unsigned G = gridDim.x * gridDim.y * gridDim.z;
    unsigned sum, cnt, mine, sp = 0u;
    for (;;) {
        sum = 0u; cnt = 0u; mine = 0u;
#pragma unroll
        for (unsigned j = 0; j < 16; ++j) { const unsigned c = xb_ld(&bar[XB_XCNT(j)]); sum += c; cnt += (c > 0u) ? 1u : 0u; mine = (j == x) ? c : mine; }
        if (sum == G) break;
        __builtin_amdgcn_s_sleep(1);
        if ((++sp & 255u) == 0u) { if (xb_ld(&bar[XB_TMO])) break; if (sp > XB_SPIN_CAP) { atomicAdd(&bar[XB_TMO], 1u); break; } }
    }
    nloc = mine > 0u ? mine : 1u; nx = cnt > 0u ? cnt : 1u;
}
__device__ __forceinline__ void xcd_barrier(const XcdBarrier& b) {
    asm volatile("s_waitcnt vmcnt(0)" ::: "memory");
    __syncthreads();
    if (threadIdx.x == 0) {
        unsigned* bar = b.bar;
        __builtin_amdgcn_s_waitcnt(0);
        unsigned nloc = b.st[0], nx = b.st[1];
        if (nloc == 0u) { xcd_barrier_complete(bar, b.x, nloc, nx); b.st[0] = nloc; b.st[1] = nx; }
        const unsigned old = xb_add(&bar[XB_XSUB(b.x)], 1u);
        const unsigned gen = old / nloc;
        if (old + 1u == (gen + 1u) * nloc) {
            __builtin_amdgcn_fence(__ATOMIC_RELEASE, "agent");
            asm volatile("s_waitcnt vmcnt(0)" ::: "memory");
            const unsigned og = xb_add(&bar[XB_TOP], 1u);
            const unsigned tg = og / nx;
            if (og + 1u == (tg + 1u) * nx) xb_add(&bar[XB_TOPGEN], 1u);
            else XB_SPIN(xb_ld(&bar[XB_TOPGEN]) == tg, bar);
            __builtin_amdgcn_fence(__ATOMIC_ACQUIRE, "agent");
            xb_add(&bar[XB_XGEN(b.x)], 1u);
            asm volatile("s_waitcnt vmcnt(0)" ::: "memory");
        } else {
            XB_SPIN(xb_ld(&bar[XB_XGEN(b.x)]) == gen, bar);
            __builtin_amdgcn_fence(__ATOMIC_ACQUIRE, "agent");
            asm volatile("s_waitcnt vmcnt(0)" ::: "memory");
        }
    }
    __syncthreads();
}

struct Args {
    const float* in[26]; float* out; unsigned char* ws; int ph_lo, ph_hi, layer_lo, layer_hi;
};
enum { I_X = 0, I_P, I_WIN, I_CAW, I_CAB, I_LCW, I_LCB, I_LWA, I_LBA, I_LWX, I_LBX, I_LAM, I_CPOS, I_PW1, I_PB1, I_PW2, I_WBR, I_WOUT, I_LNG, I_LNB, I_WR, I_BR, I_WGU, I_WDN, I_WPLE, I_WPG };

struct Frame {
    LAS unsigned char* lds;
    gu32* ctl;
    unsigned char* ws;
    int tid, lane, wave, G, bx;
};
__device__ __forceinline__ const float* inp(const Frame& F, int i) {
    const LAS unsigned* p = (const LAS unsigned*)(F.lds + PTR_OFF) + 2 * i;
    const unsigned lo = __builtin_amdgcn_readfirstlane(p[0]), hi = __builtin_amdgcn_readfirstlane(p[1]);
    return (const float*)(((unsigned long long)hi << 32) | lo);
}
#define PHASE_FENCE() do { asm volatile("" ::: "memory"); unsigned _ones = ~0u; asm volatile("" : "+s"(_ones)); int _t = wave0 * 64 + (int)__builtin_amdgcn_mbcnt_hi(_ones, __builtin_amdgcn_mbcnt_lo(_ones, 0u)); asm volatile("" : "+v"(_t)); F.tid = _t; F.lane = _t & 63; F.wave = __builtin_amdgcn_readfirstlane(_t >> 6); \
    F.ws = (unsigned char*)inp(F, 27); F.ctl = (gu32*)(F.ws + WS_CTL); } while (0)

struct CvtD { const float* src; bf16* dst; int ldw; int K; };
__device__ __forceinline__ void cvt_load(const CvtD& d, f32x4 (&v)[8], int lane) {
    const float* src = d.src + (size_t)(lane >> 3) * d.ldw + 4 * (lane & 7);
#pragma unroll
    for (int i = 0; i < 8; ++i) v[i] = *(const f32x4*)(src + (size_t)(8 * i) * d.ldw);
}
__device__ __forceinline__ void cvt_store(const CvtD& d, const f32x4 (&v)[8], LAS float* scr, int lane) {
#pragma unroll
    for (int i = 0; i < 8; ++i) { LAS float* p = scr + (8 * i + (lane >> 3)) * 33 + 4 * (lane & 7); p[0] = v[i][0]; p[1] = v[i][1]; p[2] = v[i][2]; p[3] = v[i][3]; }
    LDS_WAIT(); asm volatile("" ::: "memory");
    const int c = lane & 7;
#pragma unroll
    for (int j = 0; j < 4; ++j) { const int n = (lane >> 3) + 8 * j; const LAS float* sp = scr + (8 * c) * 33 + n;
        u32x4 o; o.x = pk2(sp[0 * 33], sp[1 * 33]); o.y = pk2(sp[2 * 33], sp[3 * 33]); o.z = pk2(sp[4 * 33], sp[5 * 33]); o.w = pk2(sp[6 * 33], sp[7 * 33]);
        *(GAS u32x4*)(d.dst + (size_t)n * d.K + 8 * c) = o; }
    LDS_WAIT(); asm volatile("" ::: "memory");
}
__device__ __forceinline__ CvtD cvt_desc(const float* W, int ldw, int k0, int n0, bf16* WT, int K, int row0) { CvtD d; d.src = W + (size_t)k0 * ldw + n0; d.dst = WT + (size_t)row0 * K + k0; d.ldw = ldw; d.K = K; return d; }

constexpr int CI_IN = 32 * 434, CI_BRI = 16 * 64, CI_OUT = 32 * 64, CI_GU = 32 * 64, CI_DN = 16 * 64, CI_PGI = 32 * 64, CI_PL = 4 * 64, CI_P1 = 32 * 4, CI_P2 = 2 * 2;
constexpr int CI_PER_LAYER = CI_IN + 3 * CI_BRI + CI_OUT + NE * CI_GU + NE * CI_DN + CI_PGI + CI_PL + 2 * CI_P1 + 2 * CI_P2;
__device__ __forceinline__ CvtD cvt_decode(Frame& F, int it) {
    const int l = it / CI_PER_LAYER; int r = it - l * CI_PER_LAYER;
    unsigned char* lwp = F.ws + WS_W + (size_t)l * LW_BYTES;
    if (r < CI_IN) { const int kb = r / 434, nb = r - kb * 434; int n0, row0;
        if (nb < 242) { n0 = 32 * nb; row0 = n0; } else { n0 = 7728 + 32 * (nb - 242); row0 = Z_MG + 32 * (nb - 242); }
        return cvt_desc(inp(F, I_WIN) + (size_t)l * DM * IN_COLS, IN_COLS, 64 * kb, n0, (bf16*)(lwp + LW_IN), DM, row0); }
    r -= CI_IN;
    if (r < 3 * CI_BRI) { const int bi = r / CI_BRI; r -= bi * CI_BRI; const int kb = r / 64, nb = r % 64;
        return cvt_desc(inp(F, I_WBR) + ((size_t)l * 3 + bi) * BW * DM, DM, 64 * kb, 32 * nb, (bf16*)(lwp + LW_BR) + (size_t)bi * BW, 3 * BW, 32 * nb); }
    r -= 3 * CI_BRI;
    if (r < CI_OUT) { const int kb = r / 64, nb = r % 64; return cvt_desc(inp(F, I_WOUT) + (size_t)l * DM * DM, DM, 64 * kb, 32 * nb, (bf16*)(lwp + LW_OUT), DM, 32 * nb); }
    r -= CI_OUT;
    if (r < NE * CI_GU) { const int e = r / CI_GU; r -= e * CI_GU; const int kb = r / 64, nb = r % 64; const int n = 32 * nb; int row0;
        if (n < DE) row0 = (n >> 7) * 256 + (n & 127); else row0 = ((n - DE) >> 7) * 256 + 128 + ((n - DE) & 127);
        return cvt_desc(inp(F, I_WGU) + ((size_t)l * NE + e) * DM * 2048, 2048, 64 * kb, n, (bf16*)(lwp + LW_GU) + (size_t)e * 2048 * DM, DM, row0); }
    r -= NE * CI_GU;
    if (r < NE * CI_DN) { const int e = r / CI_DN; r -= e * CI_DN; const int kb = r / 64, nb = r % 64;
        return cvt_desc(inp(F, I_WDN) + ((size_t)l * NE + e) * DE * DM, DM, 64 * kb, 32 * nb, (bf16*)(lwp + LW_DN) + (size_t)e * DM * DE, DE, 32 * nb); }
    r -= NE * CI_DN;
    if (r < CI_PGI) { const int kb = r / 64, nb = r % 64; return cvt_desc(inp(F, I_WPG) + (size_t)l * DM * DM, DM, 64 * kb, 32 * nb, (bf16*)(lwp + LW_PG), DM, 32 * nb); }
    r -= CI_PGI;
    if (r < CI_PL) { const int kb = r / 64, nb = r % 64; return cvt_desc(inp(F, I_WPLE) + (size_t)l * PLE * DM, DM, 64 * kb, 32 * nb, (bf16*)(lwp + LW_PLE), PLE, 32 * nb); }
    r -= CI_PL;
    if (r < 2 * CI_P1) { const int kv = r / CI_P1; r -= kv * CI_P1; const int kb = r / 4, nb = r % 4;
        return cvt_desc(inp(F, I_PW1) + ((size_t)l * 2 + kv) * 2048 * 128, 128, 64 * kb, 32 * nb, (bf16*)(lwp + LW_PHI1) + (size_t)kv * 128 * 2048, 2048, 32 * nb); }
    r -= 2 * CI_P1;
    { const int kv = r / CI_P2; r -= kv * CI_P2; const int kb = r / 2, nb = r % 2;
        return cvt_desc(inp(F, I_PW2) + ((size_t)l * 2 + kv) * 128 * 64, 64, 64 * kb, 32 * nb, (bf16*)(lwp + LW_PHI2) + (size_t)kv * 64 * 128, 128, 32 * nb); }
}

__device__ __forceinline__ void p0_prologue(const Args& a, Frame& F) {
    LAS float* scr = (LAS float*)(F.lds + RING_OFF + F.wave * 16384);
    const int gw = F.bx * NWAVES + F.wave, NGW = F.G * NWAVES;
    { int it = gw;
        if (it < DEPTH * CI_PER_LAYER) { CvtD d = cvt_decode(F, it); f32x4 v[8]; cvt_load(d, v, F.lane);
            for (;;) { const int itn = it + NGW; const bool more = itn < DEPTH * CI_PER_LAYER; CvtD dn = d; f32x4 vn[8];
                if (more) { dn = cvt_decode(F, itn); cvt_load(dn, vn, F.lane); }
                cvt_store(d, v, scr, F.lane);
                if (!more) break;
                d = dn; it = itn;
#pragma unroll
                for (int i = 0; i < 8; ++i) v[i] = vn[i]; } } }
    const size_t gt = (size_t)F.bx * NTHR + F.tid, NGT = (size_t)F.G * NTHR;
    for (size_t i = gt; i < (size_t)DEPTH * 192 * DM / 8; i += NGT) { const int l = (int)(i / (192 * DM / 8)); const size_t r = i % (192 * DM / 8);
        *(GAS u32x4*)((bf16*)(F.ws + WS_W + (size_t)l * LW_BYTES + LW_IN) + (size_t)7744 * DM + r * 8) = (u32x4){0u, 0u, 0u, 0u}; }
    const float* pLWA = inp(F, I_LWA); const float* pLWX = inp(F, I_LWX);
    { const size_t nl = (size_t)DEPTH * 8 * 256 * 128;
      for (size_t i0 = gt; i0 < nl; i0 += 4 * NGT) { float v[4];
#pragma unroll
          for (int q = 0; q < 4; ++q) { size_t i = i0 + q * NGT; if (i >= nl) i = gt; const int k = (int)(i & 127), np = (int)((i >> 7) & 255), h = (int)((i >> 15) & 7), l = (int)(i >> 18);
              const int sel = (np >> 4) & 1, j = (np >> 5) * 16 + (np & 15);
              v[q] = *(const GAS float*)((sel ? pLWX : pLWA) + (((size_t)l * 8 + h) * 128 + k) * 128 + j); }
#pragma unroll
          for (int q = 0; q < 4; ++q) { const size_t i = i0 + q * NGT; if (i < nl) { const int k = (int)(i & 127), np = (int)((i >> 7) & 255), h = (int)((i >> 15) & 7), l = (int)(i >> 18);
              ((bf16*)(F.ws + WS_W + (size_t)l * LW_BYTES + LW_LRU))[((size_t)h * 256 + np) * 128 + k] = (bf16)f2bf(v[q]); } } } }
    { const GAS f32x4* x4 = (const GAS f32x4*)inp(F, I_X); GAS u32x2* o = (GAS u32x2*)(F.ws + WS_XB); GAS u32x2* oh = (GAS u32x2*)(F.ws + WS_XH);
      const size_t nx4 = (size_t)T * DM / 4;
      for (size_t i0 = gt; i0 < nx4; i0 += 8 * NGT) { f32x4 v[8];
#pragma unroll
          for (int q = 0; q < 8; ++q) { const size_t i = i0 + q * NGT; v[q] = x4[i < nx4 ? i : gt]; }
#pragma unroll
          for (int q = 0; q < 8; ++q) { const size_t i = i0 + q * NGT; if (i < nx4) { u32x2 w; w.x = pk2(v[q][0], v[q][1]); w.y = pk2(v[q][2], v[q][3]); o[i] = w; u32x2 wh; wh.x = pkh2(v[q][0], v[q][1]); wh.y = pkh2(v[q][2], v[q][3]); oh[i] = wh; } } }
      const GAS f32x4* p4 = (const GAS f32x4*)inp(F, I_P); GAS u32x2* po = (GAS u32x2*)(F.ws + WS_PB);
      const size_t np4 = (size_t)DEPTH * T * PLE / 4;
      for (size_t i0 = gt; i0 < np4; i0 += 8 * NGT) { f32x4 v[8];
#pragma unroll
          for (int q = 0; q < 8; ++q) { const size_t i = i0 + q * NGT; v[q] = p4[i < np4 ? i : gt]; }
#pragma unroll
          for (int q = 0; q < 8; ++q) { const size_t i = i0 + q * NGT; if (i < np4) { u32x2 w; w.x = pk2(v[q][0], v[q][1]); w.y = pk2(v[q][2], v[q][3]); po[i] = w; } } } }
    if (gt < (size_t)DEPTH * 2 * 16 * 128) { const int c = (int)(gt & 127), sl = (int)((gt >> 7) & 15), kv = (int)((gt >> 11) & 1), l = (int)(gt >> 12);
        const float* pos = inp(F, I_CPOS) + ((size_t)l * 2 + kv) * 2048 + sl * 128; const float* w1 = inp(F, I_PW1) + (((size_t)l * 2 + kv) * 2048 + sl * 128) * 128;
        float s = sl == 0 ? inp(F, I_PB1)[((size_t)l * 2 + kv) * 128 + c] : 0.f;
#pragma unroll 32
        for (int k = 0; k < 128; ++k) s += pos[k] * w1[(size_t)k * 128 + c];
        ((float*)(F.ws + WS_SMALL))[gt] = s; }
}

__device__ __forceinline__ float b1eff_sum(const float* p, int c) { float v[16], s = 0.f;
#pragma unroll
    for (int i = 0; i < 16; ++i) v[i] = *(const GAS float*)(p + i * 128 + c);
#pragma unroll
    for (int i = 0; i < 16; ++i) s += v[i];
    return s; }

__device__ __forceinline__ void conv_a_phase(const Args& a, Frame& F, int l) {
    const bf16* Z = (const bf16*)(F.ws + WS_Z); bf16* YA = (bf16*)(F.ws + WS_YA);
    const float* cw = inp(F, I_CAW) + (size_t)l * 3 * BW; const float* cb = inp(F, I_CAB) + (size_t)l * BW;
    const size_t gt = (size_t)F.bx * NTHR + F.tid, NGT = (size_t)F.G * NTHR;
    for (size_t it = gt; it < (size_t)(T / 8) * (BW / 8); it += NGT) {
        const int c0 = (int)(it & 127) * 8, row0 = (int)(it >> 7) * 8, t0 = row0 & (SEQ - 1);
        float w0[8], w1[8], w2[8], bb[8];
        { const f32x4 a0 = *(const GAS f32x4*)(cw + c0), a1 = *(const GAS f32x4*)(cw + c0 + 4), b0 = *(const GAS f32x4*)(cw + BW + c0), b1 = *(const GAS f32x4*)(cw + BW + c0 + 4), c0v = *(const GAS f32x4*)(cw + 2 * BW + c0), c1v = *(const GAS f32x4*)(cw + 2 * BW + c0 + 4), d0 = *(const GAS f32x4*)(cb + c0), d1 = *(const GAS f32x4*)(cb + c0 + 4);
#pragma unroll
            for (int j = 0; j < 4; ++j) { w0[j] = a0[j]; w0[4 + j] = a1[j]; w1[j] = b0[j]; w1[4 + j] = b1[j]; w2[j] = c0v[j]; w2[4 + j] = c1v[j]; bb[j] = d0[j]; bb[4 + j] = d1[j]; } }
        float pm2[8], pm1[8];
#pragma unroll
        for (int j = 0; j < 8; ++j) { pm2[j] = 0.f; pm1[j] = 0.f; }
        if (t0 > 0) {
#pragma unroll
            for (int k = 0; k < 2; ++k) { const bf16* zr = Z + (size_t)(row0 - 2 + k) * NZ; const u32x4 ai = *(const GAS u32x4*)(zr + Z_AIN + c0), ac = *(const GAS u32x4*)(zr + Z_AC + c0);
                const unsigned aiw[4] = {ai.x, ai.y, ai.z, ai.w}, acw[4] = {ac.x, ac.y, ac.z, ac.w};
#pragma unroll
                for (int j = 0; j < 4; ++j) { const float lo = bflo(aiw[j]) * bflo(acw[j]), hi = bfhi(aiw[j]) * bfhi(acw[j]); if (k == 0) { pm2[2 * j] = lo; pm2[2 * j + 1] = hi; } else { pm1[2 * j] = lo; pm1[2 * j + 1] = hi; } } } }
        u32x4 aiv[8], acv[8], abv[8];
#pragma unroll
        for (int tt = 0; tt < 8; ++tt) { const bf16* zr = Z + (size_t)(row0 + tt) * NZ; aiv[tt] = *(const GAS u32x4*)(zr + Z_AIN + c0); acv[tt] = *(const GAS u32x4*)(zr + Z_AC + c0); abv[tt] = *(const GAS u32x4*)(zr + Z_AB + c0); }
#pragma unroll
        for (int tt = 0; tt < 8; ++tt) { const u32x4 ai = aiv[tt], ac = acv[tt], ab = abv[tt];
            const unsigned aiw[4] = {ai.x, ai.y, ai.z, ai.w}, acw[4] = {ac.x, ac.y, ac.z, ac.w}, abw[4] = {ab.x, ab.y, ab.z, ab.w};
            float p0[8]; unsigned ow[4];
#pragma unroll
            for (int j = 0; j < 4; ++j) { p0[2 * j] = bflo(aiw[j]) * bflo(acw[j]); p0[2 * j + 1] = bfhi(aiw[j]) * bfhi(acw[j]); }
#pragma unroll
            for (int j = 0; j < 4; ++j) { const float y0 = bb[2 * j] + w0[2 * j] * pm2[2 * j] + w1[2 * j] * pm1[2 * j] + w2[2 * j] * p0[2 * j], y1 = bb[2 * j + 1] + w0[2 * j + 1] * pm2[2 * j + 1] + w1[2 * j + 1] * pm1[2 * j + 1] + w2[2 * j + 1] * p0[2 * j + 1];
                ow[j] = pk2(y0 * bflo(abw[j]), y1 * bfhi(abw[j])); }
#pragma unroll
            for (int j = 0; j < 8; ++j) { pm2[j] = pm1[j]; pm1[j] = p0[j]; }
            *(GAS u32x4*)(YA + (size_t)(row0 + tt) * YP + c0) = (u32x4){ow[0], ow[1], ow[2], ow[3]}; }
    }
}

template <int PASS>
__device__ __forceinline__ void lru_phase(const Args& a, Frame& F, int l) {
    const bf16* Z = (const bf16*)(F.ws + WS_Z); GAS bf16* YB = (GAS bf16*)(F.ws + WS_YA) + 1024;
    float* aggA = (float*)(F.ws + WS_AGG); float* aggB = aggA + (size_t)BATCH * 8 * BW;
    const bf16* WL = (const bf16*)(F.ws + WS_W + (size_t)l * LW_BYTES + LW_LRU);
    const float* cw = inp(F, I_LCW) + (size_t)l * 4 * BW; const float* cb = inp(F, I_LCB) + (size_t)l * BW;
    const float* ba = inp(F, I_LBA) + (size_t)l * BW; const float* bx = inp(F, I_LBX) + (size_t)l * BW; const float* lam = inp(F, I_LAM) + (size_t)l * BW;
    LAS unsigned char* lds = F.lds + RING_OFF;
    LAS bf16* XA = (LAS bf16*)lds;
    LAS float* XC = (LAS float*)(lds + 17408);
    LAS float* AA = (LAS float*)(lds + 17408 + 32768);
    LAS float* GG = (LAS float*)(lds + 17408 + 65536);
    const int w = F.wave, lane = F.lane, fr = lane & 15, fq = lane >> 4;
    for (int wu = F.bx; wu < BATCH * 8 * 8; wu += F.G) {
        const int h = wu & 7, cg = (wu >> 3) & 7, b = wu >> 6;
        bf16x8 Bf[2][4];
#pragma unroll
        for (int nt = 0; nt < 2; ++nt)
#pragma unroll
            for (int ks = 0; ks < 4; ++ks) Bf[nt][ks] = *(const bf16x8*)(WL + ((size_t)h * 256 + 32 * w + 16 * nt + fr) * 128 + 32 * ks + 8 * fq);
        int jch = F.tid & 127, qd = F.tid >> 7; const int chs = h * 128 + jch;
        LAS float* QA = (LAS float*)(lds + 17408 + 98304);
        LAS float* QB = QA + 512; LAS float* HC = QA + 1024; LAS float* PA = QA + 1280;
        if (F.tid < 128) { float hv0 = 0.f;
            if (PASS == 2) { for (int gg = 0; gg < cg; ++gg) hv0 = aggA[((size_t)b * 8 + gg) * BW + chs] * hv0 + aggB[((size_t)b * 8 + gg) * BW + chs]; }
            HC[jch] = hv0; PA[jch] = 1.f; }
        LAS float* CWL = PA + 256;
        { int ti = F.tid; asm volatile("" : "+v"(ti)); for (int i = ti; i < 640; i += NTHR) CWL[i] = i < 512 ? *(const GAS float*)(cw + (size_t)(i >> 7) * BW + h * 128 + (i & 127)) : *(const GAS float*)(cb + h * 128 + (i - 512)); }
        float bav_u, bxv_u, sp_u;
        { const int ch = h * 128 + 16 * w + fr; bav_u = *(const GAS float*)(ba + ch); bxv_u = *(const GAS float*)(bx + ch); const float lm = *(const GAS float*)(lam + ch);
            sp_u = (lm > 15.f) ? __expf(-lm) : log1pf(__expf(-lm)); }
        __syncthreads();
        u32x4 rv[4][2];
#define LRU1_LOAD(ci_) do { int tp_ = F.tid; asm volatile("" : "+v"(tp_)); const int row_ = tp_ >> 3, cb_ = h * 128 + (tp_ & 7) * 16; \
            _Pragma("unroll") for (int k_ = 0; k_ < 4; ++k_) { const int tt_ = (8 * cg + (ci_)) * 64 + row_ - 3 + k_; \
                if (tt_ >= 0) { const bf16* zr_ = Z + (size_t)(b * SEQ + tt_) * NZ + Z_RIN + cb_; rv[k_][0] = *(const GAS u32x4*)zr_; rv[k_][1] = *(const GAS u32x4*)(zr_ + 8); } \
                else { rv[k_][0] = (u32x4){0u, 0u, 0u, 0u}; rv[k_][1] = (u32x4){0u, 0u, 0u, 0u}; } } } while (0)
        LRU1_LOAD(0);
        for (int ci = 0; ci < 8; ++ci) {
            const int c = 8 * cg + ci, t0 = c * 64;
            int tl = F.tid; asm volatile("" : "+v"(tl)); jch = tl & 127; qd = tl >> 7;
            { const int row = tl >> 3, seg = tl & 7, cbase = h * 128 + seg * 16;
                float xc[16];
#pragma unroll
                for (int j = 0; j < 4; ++j) { const f32x4 v = *(const LAS f32x4*)(CWL + 512 + seg * 16 + 4 * j); xc[4 * j] = v[0]; xc[4 * j + 1] = v[1]; xc[4 * j + 2] = v[2]; xc[4 * j + 3] = v[3]; }
#pragma unroll
                for (int k = 0; k < 4; ++k) {
                    { const u32x4 v0 = rv[k][0], v1 = rv[k][1];
                        const unsigned vw[8] = {v0.x, v0.y, v0.z, v0.w, v1.x, v1.y, v1.z, v1.w};
                        float wk[16];
#pragma unroll
                        for (int j = 0; j < 4; ++j) { const f32x4 v = *(const LAS f32x4*)(CWL + k * 128 + seg * 16 + 4 * j); wk[4 * j] = v[0]; wk[4 * j + 1] = v[1]; wk[4 * j + 2] = v[2]; wk[4 * j + 3] = v[3]; }
#pragma unroll
                        for (int j = 0; j < 8; ++j) { xc[2 * j] += wk[2 * j] * bflo(vw[j]); xc[2 * j + 1] += wk[2 * j + 1] * bfhi(vw[j]); } } }
#pragma unroll
                for (int j = 0; j < 4; ++j) *(LAS f32x4*)(XC + row * 128 + seg * 16 + 4 * j) = (f32x4){xc[4 * j], xc[4 * j + 1], xc[4 * j + 2], xc[4 * j + 3]};
#pragma unroll
                for (int j = 0; j < 4; ++j) *(LAS u32x2*)(XA + row * 136 + seg * 16 + 4 * j) = (u32x2){pk2(xc[4 * j], xc[4 * j + 1]), pk2(xc[4 * j + 2], xc[4 * j + 3])};
                if (ci + 1 < 8) LRU1_LOAD(ci + 1);
                if (PASS == 2) { const bf16* zr = Z + (size_t)(b * SEQ + t0 + row) * NZ + Z_RG + cbase; const u32x4 v0 = *(const GAS u32x4*)zr, v1 = *(const GAS u32x4*)(zr + 8);
                    const unsigned vw[8] = {v0.x, v0.y, v0.z, v0.w, v1.x, v1.y, v1.z, v1.w};
#pragma unroll
                    for (int j = 0; j < 4; ++j) *(LAS f32x4*)(GG + row * 128 + seg * 16 + 4 * j) = (f32x4){gelu_tanh(bflo(vw[2 * j])), gelu_tanh(bfhi(vw[2 * j])), gelu_tanh(bflo(vw[2 * j + 1])), gelu_tanh(bfhi(vw[2 * j + 1]))}; }
            }
            __syncthreads();
            f32x4 acc[4][2];
#pragma unroll
            for (int m = 0; m < 4; ++m) { acc[m][0] = (f32x4){0.f, 0.f, 0.f, 0.f}; acc[m][1] = (f32x4){0.f, 0.f, 0.f, 0.f}; }
#pragma unroll
            for (int ks = 0; ks < 4; ++ks)
#pragma unroll
                for (int m = 0; m < 4; ++m) { const bf16x8 Af = *(const LAS bf16x8*)(XA + (16 * m + fr) * 136 + 32 * ks + 8 * fq);
                    acc[m][0] = __builtin_amdgcn_mfma_f32_16x16x32_bf16(Af, Bf[0][ks], acc[m][0], 0, 0, 0);
                    acc[m][1] = __builtin_amdgcn_mfma_f32_16x16x32_bf16(Af, Bf[1][ks], acc[m][1], 0, 0, 0); }
            { const int j = 16 * w + fr; const float bav = bav_u, bxv = bxv_u, sp = sp_u;
#pragma unroll
                for (int m = 0; m < 4; ++m)
#pragma unroll
                    for (int r = 0; r < 4; ++r) { const int tt = 16 * m + 4 * fq + r;
                        const float rr = sigmoidf_(acc[m][0][r] + bav), ii = sigmoidf_(acc[m][1][r] + bxv);
                        const float la = -8.0f * rr * sp; const float av = __expf(la); const float mult = __builtin_amdgcn_sqrtf(neg_expm1f(2.0f * la));
                        const float xcv = XC[tt * 128 + j]; (void)av; AA[tt * 128 + j] = (float)(_Float16)la; XC[tt * 128 + j] = (float)(_Float16)(mult * ii * xcv); } }
            __syncthreads();
            if (PASS == 1) { const int row = tl >> 3, seg = tl & 7; unsigned short* LAg = (unsigned short*)(F.ws + WS_LA) + ((size_t)b * SEQ + t0 + row) * BW + h * 128 + seg * 16; unsigned short* LBg = (unsigned short*)(F.ws + WS_LB) + ((size_t)b * SEQ + t0 + row) * BW + h * 128 + seg * 16;
#pragma unroll
                for (int j = 0; j < 2; ++j) { float va[8], vb[8];
#pragma unroll
                    for (int e = 0; e < 8; ++e) { va[e] = AA[row * 128 + seg * 16 + 8 * j + e]; vb[e] = XC[row * 128 + seg * 16 + 8 * j + e]; }
                    *(GAS u32x4*)(LAg + 8 * j) = pack8h(va); *(GAS u32x4*)(LBg + 8 * j) = pack8h(vb); } }
            { float qa = 1.f, qb = 0.f;
#pragma unroll
                for (int tt = 16 * qd; tt < 16 * qd + 16; ++tt) { const float av = __expf(AA[tt * 128 + jch]); qb = av * qb + XC[tt * 128 + jch]; qa *= av; }
                QA[qd * 128 + jch] = qa; QB[qd * 128 + jch] = qb; }
            __syncthreads();
            { float hq = HC[(ci & 1) * 128 + jch];
                for (int qq = 0; qq < qd; ++qq) hq = QA[qq * 128 + jch] * hq + QB[qq * 128 + jch];
                if (PASS == 2) {
#pragma unroll
                    for (int tt = 16 * qd; tt < 16 * qd + 16; ++tt) { hq = __expf(AA[tt * 128 + jch]) * hq + XC[tt * 128 + jch];
                        YB[((size_t)b * SEQ + t0 + tt) * YP + chs] = (bf16)f2bf(hq * GG[tt * 128 + jch]); }
                    if (qd == 3) HC[((ci + 1) & 1) * 128 + jch] = hq;
                } else if (qd == 3) { HC[((ci + 1) & 1) * 128 + jch] = QA[384 + jch] * hq + QB[384 + jch];
                    PA[((ci + 1) & 1) * 128 + jch] = PA[(ci & 1) * 128 + jch] * (QA[jch] * QA[128 + jch]) * (QA[256 + jch] * QA[384 + jch]); } }
            __syncthreads();
        }
#undef LRU1_LOAD
        if (PASS == 1 && F.tid < 128) { aggA[((size_t)b * 8 + cg) * BW + chs] = PA[jch]; aggB[((size_t)b * 8 + cg) * BW + chs] = HC[jch]; }
        __syncthreads();
    }
}

__device__ __forceinline__ void compress_phase(const Args& a, Frame& F, int l) {
    const bf16* Z = (const bf16*)(F.ws + WS_Z); bf16* CMP = (bf16*)(F.ws + WS_CMP);
    LAS float* xs = (LAS float*)(F.lds + RING_OFF);
    LAS float* part = xs + 144 * 64;
    LAS float* hid = part + 4 * 8 * 128;
    for (int task = F.bx; task < 2 * BATCH * NG * 32; task += F.G) {
        const int n8 = task & 31, g = (task >> 5) & 3, b = (task >> 7) & 3, kv = task >> 9;
        const float* w1 = inp(F, I_PW1) + ((size_t)l * 2 + kv) * 2048 * 128; const float* w2 = inp(F, I_PW2) + ((size_t)l * 2 + kv) * 128 * 64;
        const float* b1e = (const float*)(F.ws + WS_SMALL) + ((size_t)l * 2 + kv) * 16 * 128;
        const int tok0 = 128 * n8, zc = (kv ? Z_VC : Z_KC) + g * 64;
        for (int i = F.tid; i < 144 * 64; i += NTHR) { const int tk = tok0 + (i >> 6); xs[i] = tk < SEQ ? bf2f(Z[(size_t)(b * SEQ + tk) * NZ + zc + (i & 63)]) : 0.f; }
        __syncthreads();
        { const int c = F.tid & 127, kq = F.tid >> 7; float acc[8];
#pragma unroll
            for (int i = 0; i < 8; ++i) acc[i] = 0.f;
            for (int k = kq * 512; k < kq * 512 + 512; ++k) { const float wv = w1[(size_t)k * 128 + c]; const int lp = k >> 6, d = k & 63;
#pragma unroll
                for (int i = 0; i < 8; ++i) acc[i] += xs[(16 * i + lp) * 64 + d] * wv; }
#pragma unroll
            for (int i = 0; i < 8; ++i) part[(kq * 8 + i) * 128 + c] = acc[i]; }
        __syncthreads();
        for (int i = F.tid; i < 8 * 128; i += NTHR) { const int c = i & 127; const float s = part[i] + part[1024 + i] + part[2048 + i] + part[3072 + i] + b1eff_sum(b1e, c); hid[i] = gelu_tanh(s); }
        __syncthreads();
        { const int i = F.tid >> 6, d = F.tid & 63; float s = 0.f;
            for (int c = 0; c < 128; ++c) s += hid[i * 128 + c] * w2[c * 64 + d];
            const int n = 8 * n8 + i; if (n >= NCMP) s = 0.f;
            CMP[((((size_t)kv * BATCH + b) * NG + g) * 256 + n) * 64 + d] = (bf16)f2bf(s); }
        __syncthreads();
    }
}

__device__ __forceinline__ void lru_pass2_phase(Frame& F, int l) {
    const bf16* Z = (const bf16*)(F.ws + WS_Z); GAS bf16* YB = (GAS bf16*)(F.ws + WS_YA) + 1024;
    const float* aggA = (const float*)(F.ws + WS_AGG); const float* aggB = aggA + (size_t)BATCH * 8 * BW;
    LAS unsigned char* lds = F.lds + RING_OFF;
    LAS float* XC = (LAS float*)(lds + 17408); LAS float* AA = (LAS float*)(lds + 17408 + 32768); LAS float* GG = (LAS float*)(lds + 17408 + 65536);
    LAS float* QA = (LAS float*)(lds + 17408 + 98304); LAS float* QB = QA + 512; LAS float* HC = QA + 1024;
    for (int wu = F.bx; wu < BATCH * 8 * 8; wu += F.G) {
        const int h = wu & 7, cg = (wu >> 3) & 7, b = wu >> 6;
        u32x4 ra[2], rb[2], rg[2];
#define LRU2_LOAD(ci_) do { int tp_ = F.tid; asm volatile("" : "+v"(tp_)); const int row_ = tp_ >> 3, seg_ = tp_ & 7; const size_t r_ = (size_t)b * SEQ + (8 * cg + (ci_)) * 64 + row_; \
            const unsigned short* LAg_ = (const unsigned short*)(F.ws + WS_LA) + r_ * BW + h * 128 + seg_ * 16; const unsigned short* LBg_ = (const unsigned short*)(F.ws + WS_LB) + r_ * BW + h * 128 + seg_ * 16; const bf16* zr_ = Z + r_ * NZ + Z_RG + h * 128 + seg_ * 16; \
            _Pragma("unroll") for (int j_ = 0; j_ < 2; ++j_) { ra[j_] = *(const GAS u32x4*)(LAg_ + 8 * j_); rb[j_] = *(const GAS u32x4*)(LBg_ + 8 * j_); rg[j_] = *(const GAS u32x4*)(zr_ + 8 * j_); } } while (0)
        LRU2_LOAD(0);
        { const int jch = F.tid & 127, chs = h * 128 + jch;
            if (F.tid < 128) { float ga_[7], gb_[7], hv0 = 0.f;
#pragma unroll
                for (int gg = 0; gg < 7; ++gg) { const int gc = gg < cg ? gg : 0; ga_[gg] = *(const GAS float*)(aggA + ((size_t)b * 8 + gc) * BW + chs); gb_[gg] = *(const GAS float*)(aggB + ((size_t)b * 8 + gc) * BW + chs); }
#pragma unroll
                for (int gg = 0; gg < 7; ++gg) if (gg < cg) hv0 = ga_[gg] * hv0 + gb_[gg];
                HC[jch] = hv0; } }
        for (int ci = 0; ci < 8; ++ci) {
            const int t0 = (8 * cg + ci) * 64;
            int tl = F.tid; asm volatile("" : "+v"(tl)); const int jch = tl & 127, qd = tl >> 7, chs = h * 128 + jch;
            { const int row = tl >> 3, seg = tl & 7;
#pragma unroll
                for (int j = 0; j < 2; ++j) { float va[8], vb[8], vg[8]; unpack8h(ra[j], va); unpack8h(rb[j], vb); unpack8(rg[j], vg);
#pragma unroll
                    for (int e = 0; e < 8; e += 4) { *(LAS f32x4*)(AA + row * 128 + seg * 16 + 8 * j + e) = (f32x4){__expf(va[e]), __expf(va[e + 1]), __expf(va[e + 2]), __expf(va[e + 3])}; *(LAS f32x4*)(XC + row * 128 + seg * 16 + 8 * j + e) = (f32x4){vb[e], vb[e + 1], vb[e + 2], vb[e + 3]};
                        *(LAS f32x4*)(GG + row * 128 + seg * 16 + 8 * j + e) = (f32x4){gelu_tanh(vg[e]), gelu_tanh(vg[e + 1]), gelu_tanh(vg[e + 2]), gelu_tanh(vg[e + 3])}; } } }
            if (ci + 1 < 8) LRU2_LOAD(ci + 1);
            __syncthreads();
            { float qa = 1.f, qb = 0.f;
#pragma unroll
                for (int tt = 16 * qd; tt < 16 * qd + 16; ++tt) { const float av = AA[tt * 128 + jch]; qb = av * qb + XC[tt * 128 + jch]; qa *= av; }
                QA[qd * 128 + jch] = qa; QB[qd * 128 + jch] = qb; }
            __syncthreads();
            { float hq = HC[(ci & 1) * 128 + jch];
                for (int qq = 0; qq < qd; ++qq) hq = QA[qq * 128 + jch] * hq + QB[qq * 128 + jch];
#pragma unroll
                for (int tt = 16 * qd; tt < 16 * qd + 16; ++tt) { hq = AA[tt * 128 + jch] * hq + XC[tt * 128 + jch];
                    YB[((size_t)b * SEQ + t0 + tt) * YP + chs] = (bf16)f2bf(hq * GG[tt * 128 + jch]); }
                if (qd == 3) HC[((ci + 1) & 1) * 128 + jch] = hq; }
            __syncthreads();
        }
#undef LRU2_LOAD
    }
}

__device__ __forceinline__ void knorm_phase(Frame& F) {
    const bf16* Z = (const bf16*)(F.ws + WS_Z); float* KMX = (float*)(F.ws + WS_KMX);
    const int gw = F.bx * NWAVES + F.wave, NGW = F.G * NWAVES;
    for (int task = gw; task < 2 * BATCH * NG * 64; task += NGW) { const int j = task & 63, g = (task >> 6) & 3, b = (task >> 8) & 3, which = task >> 10;
        const bf16* kr = Z + (size_t)(b * SEQ + 64 * j + F.lane) * NZ + (which ? Z_KW : Z_KS) + g * 64; float ss = 0.f;
        u32x4 kv8[8];
#pragma unroll
        for (int i = 0; i < 8; ++i) kv8[i] = *(const GAS u32x4*)(kr + 8 * i);
#pragma unroll
        for (int i = 0; i < 8; ++i) { const u32x4 v = kv8[i]; ss += bflo(v.x) * bflo(v.x) + bfhi(v.x) * bfhi(v.x) + bflo(v.y) * bflo(v.y) + bfhi(v.y) * bfhi(v.y) + bflo(v.z) * bflo(v.z) + bfhi(v.z) * bfhi(v.z) + bflo(v.w) * bflo(v.w) + bfhi(v.w) * bfhi(v.w); }
        ss = wave_max(ss);
        if (F.lane == 0) KMX[task] = sqrtf(ss) * 1.001f; }
}

__device__ __forceinline__ void compress_mfma_phase(Frame& F, int l, bf16* CMP) {
    typedef float f32x16 __attribute__((ext_vector_type(16)));
    const bf16* Z = (const bf16*)(F.ws + WS_Z);
    LAS unsigned char* lds = F.lds + RING_OFF;
    constexpr int XP = 144;
    LAS unsigned char* XS = lds;
    LAS float* RED = (LAS float*)(lds + 76032);
    LAS bf16* HID = (LAS bf16*)(lds + 76032 + 16512);
    const int w = F.wave, lane = F.lane, r32 = lane & 31, h = lane >> 5;
    for (int unit = F.bx; unit < 2 * BATCH * NG * 8; unit += F.G) {
        const int nb = unit & 7, g = (unit >> 3) & 3, b = (unit >> 5) & 3, kv = unit >> 7;
        const bf16* W1T = (const bf16*)(F.ws + WS_W + (size_t)l * LW_BYTES + LW_PHI1) + (size_t)kv * 128 * 2048;
        const bf16* W2T = (const bf16*)(F.ws + WS_W + (size_t)l * LW_BYTES + LW_PHI2) + (size_t)kv * 64 * 128;
        const float* b1e = (const float*)(F.ws + WS_SMALL) + ((size_t)l * 2 + kv) * 16 * 128;
        const int tok0 = 512 * nb, zc = (kv ? Z_VC : Z_KC) + g * 64;
        { u32x4 sv[9];
#pragma unroll
          for (int q = 0; q < 9; ++q) { const int i = F.tid + q * NTHR; const int ti = i >> 3, ch = i & 7, tk = tok0 + ti; const bool ok = i < 528 * 8 && tk < SEQ;
              sv[q] = *(const GAS u32x4*)(Z + (size_t)(b * SEQ + (ok ? tk : 0)) * NZ + zc + 8 * ch); if (!ok) sv[q] = (u32x4){0u, 0u, 0u, 0u}; }
#pragma unroll
          for (int q = 0; q < 9; ++q) { const int i = F.tid + q * NTHR; const int ti = i >> 3, ch = i & 7;
              if (i < 528 * 8) *(LAS u32x4*)(XS + ((ti & 15) * 33 + (ti >> 4)) * XP + ch * 16) = sv[q]; } }
        __syncthreads();
        const int ct = w & 3, lh = w >> 2;
        f32x16 acc;
#pragma unroll
        for (int i = 0; i < 16; ++i) acc[i] = 0.f;
        const bf16* wrow = W1T + (size_t)(32 * ct + r32) * 2048 + 8 * h;
        { bf16x8 wa[4][4], wb[4][4]; const int l0 = 16 * lh;
#define CMP_LOADW(dst, lb) { _Pragma("unroll") for (int q = 0; q < 4; ++q) _Pragma("unroll") for (int ks = 0; ks < 4; ++ks) dst[q][ks] = *(const GAS bf16x8*)(wrow + ((lb) + q) * 64 + 16 * ks); }
#define CMP_MMA(src, lb) { _Pragma("unroll") for (int q = 0; q < 4; ++q) { const int ll = (lb) + q; const LAS unsigned char* xr = XS + ((ll & 15) * 33 + (ll >> 4) + r32) * XP + 16 * h; \
            _Pragma("unroll") for (int ks = 0; ks < 4; ++ks) { const bf16x8 af = *(const LAS bf16x8*)(xr + 32 * ks); acc = __builtin_amdgcn_mfma_f32_32x32x16_bf16(af, src[q][ks], acc, 0, 0, 0); } } }
          CMP_LOADW(wa, l0) CMP_LOADW(wb, l0 + 4) CMP_MMA(wa, l0) CMP_LOADW(wa, l0 + 8) CMP_MMA(wb, l0 + 4) CMP_LOADW(wb, l0 + 12) CMP_MMA(wa, l0 + 8) CMP_MMA(wb, l0 + 12)
#undef CMP_LOADW
#undef CMP_MMA
        }
        if (lh == 1) {
#pragma unroll
            for (int r = 0; r < 16; ++r) RED[((r & 3) + 8 * (r >> 2) + 4 * h) * 129 + 32 * ct + r32] = acc[r]; }
        __syncthreads();
        if (lh == 0) { const float bias = b1eff_sum(b1e, 32 * ct + r32);
#pragma unroll
            for (int r = 0; r < 16; ++r) { const int n = (r & 3) + 8 * (r >> 2) + 4 * h; const float v = acc[r] + RED[n * 129 + 32 * ct + r32] + bias; HID[n * 136 + 32 * ct + r32] = (bf16)f2bf(gelu_tanh(v)); } }
        __syncthreads();
        if (w < 2) {
            f32x16 a2;
#pragma unroll
            for (int i = 0; i < 16; ++i) a2[i] = 0.f;
            bf16x8 w2[8];
#pragma unroll
            for (int ks = 0; ks < 8; ++ks) w2[ks] = *(const GAS bf16x8*)(W2T + (size_t)(32 * w + r32) * 128 + 16 * ks + 8 * h);
#pragma unroll
            for (int ks = 0; ks < 8; ++ks) { const bf16x8 af = *(const LAS bf16x8*)(HID + r32 * 136 + 16 * ks + 8 * h);
                a2 = __builtin_amdgcn_mfma_f32_32x32x16_bf16(af, w2[ks], a2, 0, 0, 0); }
#pragma unroll
            for (int r = 0; r < 16; ++r) { const int n = 32 * nb + (r & 3) + 8 * (r >> 2) + 4 * h; const float v = n < NCMP ? a2[r] : 0.f;
                CMP[((((size_t)kv * BATCH + b) * NG + g) * 256 + n) * 64 + 32 * w + r32] = (bf16)f2bf(v); } }
        __syncthreads();
    }
}

__device__ __forceinline__ float dot64(const unsigned (&qw)[32], const bf16* krow) {
    const u32x4* kp = (const u32x4*)krow; float s = 0.f;
#pragma unroll
    for (int i = 0; i < 8; ++i) { const u32x4 kv = kp[i]; const unsigned kw[4] = {kv.x, kv.y, kv.z, kv.w};
#pragma unroll
        for (int j = 0; j < 4; ++j) { s += bflo(qw[4 * i + j]) * bflo(kw[j]); s += bfhi(qw[4 * i + j]) * bfhi(kw[j]); } }
    return s;
}
#define WAVE_SYNC() do { asm volatile("s_waitcnt lgkmcnt(0)" ::: "memory"); __builtin_amdgcn_wave_barrier(); } while (0)
__device__ __forceinline__ void nsa_naive_phase(const Args& a, Frame& F, int l) {
    const bf16* Z = (const bf16*)(F.ws + WS_Z); bf16* YC = (bf16*)(F.ws + WS_YA) + 2048;
    const bf16* CK = (const bf16*)(F.ws + WS_CMP); const bf16* CV = CK + (size_t)BATCH * NG * 256 * 64;
    LAS float* pl = (LAS float*)(F.lds + RING_OFF) + F.wave * 4096;
    const int lane = F.lane; const int gw = F.bx * NWAVES + F.wave, NGW = F.G * NWAVES;
    for (int task = gw; task < BATCH * NG * SEQ; task += NGW) {
        const int t = task & (SEQ - 1), g = (task >> 12) & 3, b = task >> 14;
        const size_t row = (size_t)b * SEQ + t; const bf16* zrow = Z + row * NZ; const bf16* zb = Z + (size_t)b * SEQ * NZ;
        const bf16* ck = CK + ((size_t)b * NG + g) * 256 * 64; const bf16* cv = CV + ((size_t)b * NG + g) * 256 * 64;
        const int nvis = t >= 31 ? ((t - 31) >> 4) + 1 : 0;
        float ocmp[4], oslc[4], owin[4], ssum[4], wsum[4];
#pragma unroll
        for (int r = 0; r < 4; ++r) { const int h = 4 * g + r; const float slope = exp2f(-0.5f * (float)(h + 1));
            unsigned qw[32]; { const unsigned* qp = (const unsigned*)(zrow + Z_Q + h * 64);
#pragma unroll
                for (int i = 0; i < 32; ++i) qw[i] = qp[i]; }
            float sc[4]; float mx = -INFINITY;
#pragma unroll
            for (int c = 0; c < 4; ++c) { const int n = lane + 64 * c; float s = -INFINITY;
                if (n < nvis) s = dot64(qw, ck + (size_t)n * 64) * 0.125f - slope * (float)(t - 16 * n - 31);
                sc[c] = s; mx = fmaxf(mx, s); }
            mx = wave_max(mx); float sum = 0.f;
#pragma unroll
            for (int c = 0; c < 4; ++c) { const int n = lane + 64 * c; const float p = (n < nvis) ? __expf(sc[c] - mx) : 0.f; sc[c] = p; sum += p; }
            sum = wave_sum(sum); const float inv = nvis > 0 ? 1.0f / sum : 0.f;
#pragma unroll
            for (int c = 0; c < 4; ++c) pl[r * 256 + lane + 64 * c] = sc[c] * inv; }
        WAVE_SYNC();
#pragma unroll
        for (int r = 0; r < 4; ++r) ocmp[r] = 0.f;
        for (int n = 0; n < nvis; ++n) { const float v = bf2f(cv[(size_t)n * 64 + lane]);
#pragma unroll
            for (int r = 0; r < 4; ++r) ocmp[r] += pl[r * 256 + n] * v; }
        float imp = 0.f;
#pragma unroll
        for (int r = 0; r < 4; ++r) { const int n0 = 4 * lane; float s = pl[r * 256 + n0] + pl[r * 256 + n0 + 1] + pl[r * 256 + n0 + 2] + 0.5f * pl[r * 256 + n0 + 3];
            if (lane > 0) s += 0.5f * pl[r * 256 + n0 - 1]; imp += s; }
        WAVE_SYNC();
        const int jt = t >> 6;
        const float val = (lane == 0 || lane == jt) ? 1e9f : (lane <= jt ? imp : -1e9f);
        int rank = 0;
        for (int i = 0; i < 64; ++i) { const float vi = __shfl(val, i); rank += ((vi > val) || (vi == val && i < lane)) ? 1 : 0; }
        const unsigned long long mask = __ballot(rank < TOPN);
#if NSA_XCHK
        if (lane == 0) ((unsigned long long*)(F.ws + WS_PL))[task] = mask;
#endif
#pragma unroll
        for (int r = 0; r < 4; ++r) { const int h = 4 * g + r; const float slope = exp2f(-0.5f * (float)(h + 1));
            unsigned qw[32]; { const unsigned* qp = (const unsigned*)(zrow + Z_Q + h * 64);
#pragma unroll
                for (int i = 0; i < 32; ++i) qw[i] = qp[i]; }
            float ss[16]; float mx = -INFINITY; unsigned long long mm = mask;
#pragma unroll
            for (int bi = 0; bi < 16; ++bi) { const int j = __builtin_ctzll(mm); mm &= mm - 1; const int pos = 64 * j + lane; const int dist = t - pos; float s = -INFINITY;
                if (dist >= 0) s = dot64(qw, zb + (size_t)pos * NZ + Z_KS + g * 64) * 0.125f - slope * (float)dist;
                ss[bi] = s; mx = fmaxf(mx, s); }
            mx = wave_max(mx); float sum = 0.f;
#pragma unroll
            for (int bi = 0; bi < 16; ++bi) { const float p = __expf(ss[bi] - mx); sum += p; pl[r * 1024 + bi * 64 + lane] = p; }
            ssum[r] = wave_sum(sum); }
        WAVE_SYNC();
#pragma unroll
        for (int r = 0; r < 4; ++r) oslc[r] = 0.f;
        { unsigned long long mm = mask;
            for (int bi = 0; bi < 16; ++bi) { const int j = __builtin_ctzll(mm); mm &= mm - 1;
                const int kmax = (t - 64 * j) >= 63 ? 64 : (t - 64 * j + 1);
                for (int k = 0; k < kmax; ++k) { const float v = bf2f(zb[(size_t)(64 * j + k) * NZ + Z_VS + g * 64 + lane]);
#pragma unroll
                    for (int r = 0; r < 4; ++r) oslc[r] += pl[r * 1024 + bi * 64 + k] * v; } } }
        WAVE_SYNC();
#pragma unroll
        for (int r = 0; r < 4; ++r) { const int h = 4 * g + r; const float slope = exp2f(-0.5f * (float)(h + 1));
            unsigned qw[32]; { const unsigned* qp = (const unsigned*)(zrow + Z_Q + h * 64);
#pragma unroll
                for (int i = 0; i < 32; ++i) qw[i] = qp[i]; }
            float ss[8]; float mx = -INFINITY;
#pragma unroll
            for (int c = 0; c < 8; ++c) { const int i = lane + 64 * c; const int pos = t - (WIN - 1) + i; float s = -INFINITY;
                if (pos >= 0) s = dot64(qw, zb + (size_t)pos * NZ + Z_KW + g * 64) * 0.125f - slope * (float)(WIN - 1 - i);
                ss[c] = s; mx = fmaxf(mx, s); }
            mx = wave_max(mx); float sum = 0.f;
#pragma unroll
            for (int c = 0; c < 8; ++c) { const float p = __expf(ss[c] - mx); sum += p; pl[r * 512 + lane + 64 * c] = p; }
            wsum[r] = wave_sum(sum); }
        WAVE_SYNC();
#pragma unroll
        for (int r = 0; r < 4; ++r) owin[r] = 0.f;
        { const int i0 = t >= WIN - 1 ? 0 : (WIN - 1 - t);
            for (int i = i0; i < WIN; ++i) { const int pos = t - (WIN - 1) + i; const float v = bf2f(zb[(size_t)pos * NZ + Z_VW + g * 64 + lane]);
#pragma unroll
                for (int r = 0; r < 4; ++r) owin[r] += pl[r * 512 + i] * v; } }
        WAVE_SYNC();
#pragma unroll
        for (int r = 0; r < 4; ++r) { const int h = 4 * g + r;
            const float g0 = sigmoidf_(bf2f(zrow[Z_NG + h * 3 + 0])), g1 = sigmoidf_(bf2f(zrow[Z_NG + h * 3 + 1])), g2 = sigmoidf_(bf2f(zrow[Z_NG + h * 3 + 2]));
            const float o = g0 * ocmp[r] + g1 * oslc[r] / ssum[r] + g2 * owin[r] / wsum[r];
            YC[row * YP + h * 64 + lane] = (bf16)f2bf(o); }
    }
}

namespace nsa {
typedef float f32x16 __attribute__((ext_vector_type(16)));
typedef short s16x4 __attribute__((ext_vector_type(4)));
constexpr int TB = 8192;
constexpr int L_K = 0, L_V = 3 * TB, L_IMP = 6 * TB, L_MASK = L_IMP + 4 * 64 * 65 * 4, L_KMX = L_MASK + 512  , L_QN = L_KMX + 512  , L_GT = L_QN + 2048  , L_END = L_GT + 6144;
constexpr int L_Y = L_IMP;
static_assert(L_END <= MISC_OFF && 8 * 32 * 64 * 4 <= 4 * 64 * 65 * 4, "nsa lds");
constexpr float LOG2E = 1.4426950408889634f;
__device__ __forceinline__ unsigned cvtpk(float lo, float hi) { typedef float f2 __attribute__((ext_vector_type(2))); typedef __bf16 b2 __attribute__((ext_vector_type(2))); f2 v = {lo, hi}; b2 b = __builtin_convertvector(v, b2); return __builtin_bit_cast(unsigned, b); }
__device__ __forceinline__ s16x4 vtr(const LAS unsigned char* p) { typedef short v4 __attribute__((ext_vector_type(4))); return __builtin_bit_cast(s16x4, __builtin_amdgcn_ds_read_tr16_b64_v4i16((LAS v4*)p)); }
#define MFMA32(a, b, c) __builtin_amdgcn_mfma_f32_32x32x16_bf16((a), (b), (c), 0, 0, 0)

struct Lane { int lane, tq; };

template <int MODE, int MK  , bool FIRST, class ValidF>
__device__ __forceinline__ void tile_compute(const LAS unsigned char* Kb, const LAS unsigned char* Vb, const bf16x8 (&qf)[4], const float c0, const float sbk,
                                             const bool lv, const ValidF& valid, float& m, float& l, f32x16 (&o)[2], LAS float* imp, const Lane& L) {
    int ln = L.lane; asm volatile("" : "+v"(ln));
    const int r32 = ln & 31, hh = ln >> 5;
    unsigned kofs[4], vofs[2];
#pragma unroll
    for (int ks = 0; ks < 4; ++ks) kofs[ks] = (unsigned)(r32 * 128 + (((2 * ks + hh) ^ (r32 & 7)) << 4));
    { const int q4 = (ln & 15) >> 2, p4 = ln & 3, blk = (ln >> 4) & 1, cc0 = 2 * blk + (p4 >> 1), kk = 4 * hh + q4;
#pragma unroll
        for (int dt = 0; dt < 2; ++dt) vofs[dt] = (unsigned)((4 * hh + q4) * 128 + (((cc0 + 4 * dt) ^ kk) << 4) + 8 * (p4 & 1)); }
    f32x16 p[2];
    const float cref = c0 + sbk * (float)(4 * hh) - ((MODE == 2 && !FIRST) || MODE == 1 ? m : 0.f);
#pragma unroll
    for (int mt = 0; mt < 2; ++mt)
#pragma unroll
        for (int r = 0; r < 16; ++r) p[mt][r] = fmaf(sbk, (float)(32 * mt + (r & 3) + 8 * (r >> 2)), cref);
#pragma unroll
    for (int ks = 0; ks < 4; ++ks)
#pragma unroll
        for (int mt = 0; mt < 2; ++mt) { const bf16x8 a = *(const LAS bf16x8*)(Kb + kofs[ks] + mt * 4096); p[mt] = MFMA32(a, qf[ks], p[mt]); }
    if (MK != 0) {
#pragma unroll
        for (int mt = 0; mt < 2; ++mt)
#pragma unroll
            for (int r = 0; r < 16; ++r) { const int kc = 32 * mt + (r & 3) + 8 * (r >> 2); const bool ok = (MK == 2) ? valid(kc + 4 * hh) : lv; p[mt][r] = ok ? p[mt][r] : -INFINITY; } }
    if (MODE != 1) {
        float tmax = fmaxf(p[0][0], p[1][0]);
#pragma unroll
        for (int r = 1; r < 16; ++r) tmax = fmaxf(tmax, fmaxf(p[0][r], p[1][r]));
        tmax = fmaxf(tmax, __shfl_xor(tmax, 32));
        if (MODE == 0) {
            const float mn = fmaxf(m, tmax); const float mm = (mn == -INFINITY) ? 0.f : mn; l *= __builtin_amdgcn_exp2f(m - mm); m = mn;
#pragma unroll
            for (int mt = 0; mt < 2; ++mt)
#pragma unroll
                for (int r = 0; r < 16; ++r) p[mt][r] -= mm;
        } else if (FIRST) {
            m = tmax;
#pragma unroll
            for (int mt = 0; mt < 2; ++mt)
#pragma unroll
                for (int r = 0; r < 16; ++r) p[mt][r] -= tmax;
        } else if (__any(tmax > 8.0f)) {
            const float dl = fmaxf(tmax, 0.f); m += dl; const float f = __builtin_amdgcn_exp2f(-dl); l *= f;
#pragma unroll
            for (int mt = 0; mt < 2; ++mt)
#pragma unroll
                for (int r = 0; r < 16; ++r) p[mt][r] -= dl;
#pragma unroll
            for (int i = 0; i < 16; ++i) { o[0][i] *= f; o[1][i] *= f; } }
    }
    float ls = 0.f;
#pragma unroll
    for (int mt = 0; mt < 2; ++mt)
#pragma unroll
        for (int r = 0; r < 16; ++r) { const float e = __builtin_amdgcn_exp2f(p[mt][r]); p[mt][r] = e; ls += e; }
    l += ls;
    if (MODE == 0) return;
    if (MODE == 1) {
        float av[8], bv[8];
#pragma unroll
        for (int mt = 0; mt < 2; ++mt)
#pragma unroll
            for (int g4 = 0; g4 < 4; ++g4) { const float h3 = 0.5f * p[mt][4 * g4 + 3]; av[mt * 4 + g4] = (p[mt][4 * g4] + p[mt][4 * g4 + 1]) + (p[mt][4 * g4 + 2] + h3); bv[mt * 4 + g4] = h3; }
#pragma unroll
        for (int i = 0; i < 8; ++i) imp[8 * (i >> 2) + 2 * (i & 3) + hh] += av[i];
        asm volatile("s_waitcnt lgkmcnt(0)" ::: "memory"); __builtin_amdgcn_wave_barrier();
#pragma unroll
        for (int i = 0; i < 8; ++i) imp[8 * (i >> 2) + 2 * (i & 3) + hh + 1] += bv[i];
        asm volatile("s_waitcnt lgkmcnt(0)" ::: "memory"); __builtin_amdgcn_wave_barrier();
    }
    bf16x8 pf[2][2];
#pragma unroll
    for (int mt = 0; mt < 2; ++mt)
#pragma unroll
        for (int sg = 0; sg < 2; ++sg) { u32x4 w; w.x = cvtpk(p[mt][8 * sg], p[mt][8 * sg + 1]); w.y = cvtpk(p[mt][8 * sg + 2], p[mt][8 * sg + 3]); w.z = cvtpk(p[mt][8 * sg + 4], p[mt][8 * sg + 5]); w.w = cvtpk(p[mt][8 * sg + 6], p[mt][8 * sg + 7]);
            pf[mt][sg] = __builtin_bit_cast(bf16x8, w); }
#pragma unroll
    for (int dt = 0; dt < 2; ++dt)
#pragma unroll
        for (int mt = 0; mt < 2; ++mt)
#pragma unroll
            for (int sg = 0; sg < 2; ++sg) { const LAS unsigned char* vp = Vb + vofs[dt] + (32 * mt + 16 * sg) * 128;
                const s16x4 lo = vtr(vp), hi = vtr(vp + 8 * 128); const bf16x8 vf = __builtin_shufflevector(lo, hi, 0, 1, 2, 3, 4, 5, 6, 7);
                o[dt] = MFMA32(vf, pf[mt][sg], o[dt]); }
}
}

__device__ __forceinline__ void nsa_mfma_phase(Frame& F, int l, bf16* YC, int ypitch) {
    using namespace nsa;
    const bf16* Z = (const bf16*)(F.ws + WS_Z);
    const bf16* CK = (const bf16*)(F.ws + WS_CMP); const bf16* CV = CK + (size_t)BATCH * NG * 256 * 64;
    LAS unsigned char* lds = F.lds + RING_OFF;
    LAS float* IMP = (LAS float*)(lds + L_IMP); LAS unsigned long long* MASK = (LAS unsigned long long*)(lds + L_MASK);
    const int tid = F.tid, lane = F.lane, w = F.wave;
    Lane L; L.lane = lane; L.tq = 32 * (w & 1) + (lane & 31);
    const int hr = w >> 1;
    const int drow = 8 * w + (lane >> 3), dchk = (lane & 7) ^ ((lane >> 3) & 7);
    const unsigned loffZ = (unsigned)(drow * (NZ * 2) + dchk * 16), loffC = (unsigned)(drow * 128 + dchk * 16);
#define NSA_YL() ({ int lx_ = lane; asm volatile("" : "+v"(lx_)); (LAS float*)(lds + L_Y) + w * 2048 + lx_; })
#define NSA_ROW() ({ int lx_ = lane; asm volatile("" : "+v"(lx_)); (size_t)b * SEQ + 64 * c + 32 * (w & 1) + (lx_ & 31); })
#define NSA_IMPW() ({ int lx_ = lane; asm volatile("" : "+v"(lx_)); IMP + (hr * 64 + 32 * (w & 1) + (lx_ & 31)) * 65; })
    const unsigned ldsb = (unsigned)(size_t)(lds) + (unsigned)w * 1024u;
#define NSA_GLDS(gp, dst) do { unsigned keep_; asm volatile("s_mov_b32 %0, m0\n\ts_mov_b32 m0, %2\n\ts_nop 0\n\tglobal_load_lds_dwordx4 %1, off\n\ts_mov_b32 m0, %0" : "=&s"(keep_) : "v"(gp), "s"(dst) : "memory"); } while (0)
#define NSA_ISSUE(slot, Ksrc, Vsrc, loff) do { unsigned lo_ = (loff); asm volatile("" : "+v"(lo_));     \
        NSA_GLDS((const char*)(Ksrc) + lo_, (unsigned)__builtin_amdgcn_readfirstlane(ldsb + L_K + (slot) * TB)); \
        NSA_GLDS((const char*)(Vsrc) + lo_, (unsigned)__builtin_amdgcn_readfirstlane(ldsb + L_V + (slot) * TB)); } while (0)
#define NSA_WAIT_BAR(n) asm volatile("s_waitcnt vmcnt(" #n ") lgkmcnt(0)\n\ts_barrier" ::: "memory")
    const int vcu = (F.G % 8 == 0) ? (F.bx % 8) * (F.G / 8) + F.bx / 8 : F.bx;
    for (int idx = vcu; idx < BATCH * NG * 64; idx += F.G) {
        const int g = idx >> 8, wv = idx & 255, b = wv >> 6, qq = (wv >> 4) & 3, sx = wv & 15;
        const int cb = 16 * ((qq + (g < 2 ? 2 : 0)) & 3) + sx; const int c = (g & 1) ? 63 - cb : cb;
        const int head = 4 * g + hr; const int t = 64 * c + L.tq; const size_t row = (size_t)b * SEQ + t;
        const float slope2 = exp2f(-0.5f * (float)(head + 1)) * LOG2E; const float scale2 = 0.125f * LOG2E;
        bf16x8 qf[4];
        u32x4 qv4[4]; float kmx_ = 0.f; unsigned short g0_, g1_h, g2_h;
        { int hq = lane; asm volatile("" : "+v"(hq)); const bf16* qp = Z + NSA_ROW() * NZ + Z_Q + head * 64 + 8 * (hq >> 5);
#pragma unroll
          for (int ks = 0; ks < 4; ++ks) qv4[ks] = *(const GAS u32x4*)(qp + 16 * ks);
          int tk = tid; asm volatile("" : "+v"(tk)); if (tk < 128) kmx_ = *(const GAS float*)((const float*)(F.ws + WS_KMX) + (((tk >> 6) * BATCH + b) * NG + g) * 64 + (tk & 63));
          const bf16* gp = Z + NSA_ROW() * NZ + Z_NG + head * 3; g0_ = *(const GAS unsigned short*)(gp); g1_h = *(const GAS unsigned short*)(gp + 1); g2_h = *(const GAS unsigned short*)(gp + 2); }
#pragma unroll
        for (int ks = 0; ks < 4; ++ks) { const u32x4 qv = qv4[ks];
            u32x4 qs; qs.x = cvtpk(bflo(qv.x) * scale2, bfhi(qv.x) * scale2); qs.y = cvtpk(bflo(qv.y) * scale2, bfhi(qv.y) * scale2); qs.z = cvtpk(bflo(qv.z) * scale2, bfhi(qv.z) * scale2); qs.w = cvtpk(bflo(qv.w) * scale2, bfhi(qv.w) * scale2);
            qf[ks] = __builtin_bit_cast(bf16x8, qs); }
        f32x16 o[2];
        const bf16* zb = Z + (size_t)b * SEQ * NZ;
        { float ss = 0.f;
#pragma unroll
            for (int ks = 0; ks < 4; ++ks) { const u32x4 qq = __builtin_bit_cast(u32x4, qf[ks]); ss += bflo(qq.x) * bflo(qq.x) + bfhi(qq.x) * bfhi(qq.x) + bflo(qq.y) * bflo(qq.y) + bfhi(qq.y) * bfhi(qq.y) + bflo(qq.z) * bflo(qq.z) + bfhi(qq.z) * bfhi(qq.z) + bflo(qq.w) * bflo(qq.w) + bfhi(qq.w) * bfhi(qq.w); }
            ss += __shfl_xor(ss, 32); ((LAS float*)(lds + L_QN))[w * 64 + lane] = sqrtf(ss) * 1.001f;
            int tk = tid; asm volatile("" : "+v"(tk)); if (tk < 128) ((LAS float*)(lds + L_KMX))[tk] = kmx_; }
        { int lg_ = lane; asm volatile("" : "+v"(lg_)); LAS float* gt = (LAS float*)(lds + L_GT) + w * 192 + lg_;
            gt[0] = sigmoidf_(__builtin_bit_cast(float, (unsigned)g0_ << 16)); gt[64] = sigmoidf_(__builtin_bit_cast(float, (unsigned)g1_h << 16)); gt[128] = sigmoidf_(__builtin_bit_cast(float, (unsigned)g2_h << 16)); }
        { int ti = tid; asm volatile("" : "+v"(ti)); for (int i = ti; i < 4 * 64 * 65; i += NTHR) IMP[i] = 0.f; }
        asm volatile("s_waitcnt vmcnt(0)" ::: "memory");
        const int nvis = t >= 31 ? ((t - 31) >> 4) + 1 : 0;
        const int ntc = (4 * c + 3 + 63) >> 6;
        const bf16* ckb = CK + ((size_t)b * NG + g) * 256 * 64; const bf16* cvb = CV + ((size_t)b * NG + g) * 256 * 64;
        float m = -INFINITY, lsum = 0.f;
#pragma unroll
        for (int i = 0; i < 16; ++i) { o[0][i] = 0.f; o[1][i] = 0.f; }
        for (int pass = 0; pass < 2; ++pass) {
            const bool fresh = (pass == 0) || (ntc > 3);
            if (fresh) { NSA_ISSUE(0, ckb, cvb, loffC);
                if (ntc > 1) NSA_ISSUE(1, ckb + 64 * 64, cvb + 64 * 64, loffC); }
            for (int tt = 0; tt < ntc; ++tt) {
                if (tt + 1 < ntc) NSA_WAIT_BAR(2); else NSA_WAIT_BAR(0);
                if (fresh && tt + 2 < ntc) NSA_ISSUE((tt + 2) % 3, ckb + (size_t)(tt + 2) * 64 * 64, cvb + (size_t)(tt + 2) * 64 * 64, loffC);
                const int n0 = 64 * tt; int nv = nvis; asm volatile("" : "+v"(nv));
                auto valid = [&](int koff) { return (n0 + koff) < nv; };
                const LAS unsigned char* Kb = lds + L_K + (tt % 3) * TB; const LAS unsigned char* Vb = lds + L_V + (tt % 3) * TB;
                if (pass == 0) tile_compute<0, 2, false>(Kb, Vb, qf, slope2 * 16.f * (float)n0, slope2 * 16.f, true, valid, m, lsum, o, IMP, L);
                else tile_compute<1, 2, false>(Kb, Vb, qf, slope2 * 16.f * (float)n0, slope2 * 16.f, true, valid, m, lsum, o, NSA_IMPW() + 16 * tt, L);
            }
            NSA_WAIT_BAR(0);
            if (pass == 0) { const float lt = lsum + __shfl_xor(lsum, 32); m = (lt > 0.f) ? m + __log2f(lt) : 0.f; lsum = 0.f; }
        }
        if (c < TOPN) { if (lane < 8) MASK[8 * w + lane] = (2ull << c) - 1ull; }
        else
#pragma unroll 1
        for (int i = 0; i < 8; ++i) { int tq = 8 * w + i; asm volatile("" : "+s"(tq)); int ls = lane; asm volatile("" : "+v"(ls)); const float v = (IMP[(0 * 64 + tq) * 65 + ls] + IMP[(1 * 64 + tq) * 65 + ls]) + (IMP[(2 * 64 + tq) * 65 + ls] + IMP[(3 * 64 + tq) * 65 + ls]);
            const unsigned key = (lane == 0 || lane == c) ? 0xFFFFFFFFu : (lane <= c ? __builtin_bit_cast(unsigned, v) + 1u : 0u);
            unsigned cur = 0u;
#pragma unroll
            for (int bit = 31; bit >= 0; --bit) { const unsigned t = cur | (1u << bit); const int cnt = __builtin_popcountll(__ballot(key >= t)); cur = cnt >= TOPN ? t : cur; }
            const unsigned long long gt_ = __ballot(key > cur); unsigned long long eq_ = __ballot(key == cur); const int need = TOPN - __builtin_popcountll(gt_);
            unsigned long long pick = 0ull;
            for (int k = 0; k < need; ++k) { const unsigned long long b1 = eq_ & (0ull - eq_); pick |= b1; eq_ ^= b1; }
            const unsigned long long mk = gt_ | pick;
            if (lane == 0) MASK[tq] = mk; }
#if NSA_XCHK == 1
        __syncthreads();
        if (tid < 64) MASK[tid] = ((const unsigned long long*)(F.ws + WS_PL))[((size_t)(b * NG + g) << 12) + 64 * c + tid];
#endif
        __syncthreads();
        unsigned long long mymask = 0ull, uni_wg, uni_w;
        { int lm = lane; asm volatile("" : "+v"(lm)); const unsigned long long ml = MASK[lm]; unsigned lo = (unsigned)ml, hi = (unsigned)(ml >> 32); unsigned lo2 = ((lane >> 5) == (w & 1)) ? lo : 0u, hi2 = ((lane >> 5) == (w & 1)) ? hi : 0u;
#pragma unroll
            for (int ofs = 1; ofs < 64; ofs <<= 1) { lo |= __shfl_xor(lo, ofs); hi |= __shfl_xor(hi, ofs); lo2 |= __shfl_xor(lo2, ofs); hi2 |= __shfl_xor(hi2, ofs); }
            const unsigned long long causal = (c == 63) ? ~0ull : ((2ull << c) - 1ull);
            uni_wg = (((unsigned long long)(unsigned)__builtin_amdgcn_readfirstlane(hi) << 32) | (unsigned)__builtin_amdgcn_readfirstlane(lo)) & causal;
            uni_w = (((unsigned long long)(unsigned)__builtin_amdgcn_readfirstlane(hi2) << 32) | (unsigned)__builtin_amdgcn_readfirstlane(lo2)) & causal;
            (void)mymask; }
        { float g0; { int lg_ = lane; asm volatile("" : "+v"(lg_)); g0 = ((LAS float*)(lds + L_GT))[w * 192 + lg_]; }
            LAS float* YL = NSA_YL();
#pragma unroll
            for (int i = 0; i < 16; ++i) { YL[64 * i] = g0 * o[0][i]; YL[64 * (16 + i)] = g0 * o[1][i]; } }
        asm volatile("s_waitcnt vmcnt(0)" ::: "memory");
        {
            m = -INFINITY; lsum = 0.f;
#pragma unroll
            for (int i = 0; i < 16; ++i) { o[0][i] = 0.f; o[1][i] = 0.f; }
            unsigned long long rem = uni_wg;
            int j = 63 - __builtin_clzll(rem); rem &= ~(1ull << j);
            NSA_ISSUE(0, zb + (size_t)(64 * j) * NZ + Z_KS + g * 64, zb + (size_t)(64 * j) * NZ + Z_VS + g * 64, loffZ);
            int jn = -1;
            if (rem) { jn = 63 - __builtin_clzll(rem); rem &= ~(1ull << jn); NSA_ISSUE(1, zb + (size_t)(64 * jn) * NZ + Z_KS + g * 64, zb + (size_t)(64 * jn) * NZ + Z_VS + g * 64, loffZ); }
            int slot = 0;
            for (;;) {
                if (jn >= 0) NSA_WAIT_BAR(2); else NSA_WAIT_BAR(0);
                int jnn = -1;
                if (rem) { jnn = 63 - __builtin_clzll(rem); rem &= ~(1ull << jnn); const int s2 = slot >= 1 ? slot - 1 : 2;
                    NSA_ISSUE(s2, zb + (size_t)(64 * jnn) * NZ + Z_KS + g * 64, zb + (size_t)(64 * jnn) * NZ + Z_VS + g * 64, loffZ); }
                bool live = (uni_w >> j) & 1ull;
                unsigned long long mym; { int lq = lane; asm volatile("" : "+v"(lq)); mym = MASK[32 * (w & 1) + (lq & 31)]; }
                if (live && j != c) { const bool selj0 = (mym >> j) & 1ull;
                    const float bound = ((LAS float*)(lds + L_QN))[w * 64 + lane] * ((LAS float*)(lds + L_KMX))[j] + slope2 * (float)(64 * (j - c) + 63) - m; live = !__all(!selj0 || bound < -40.0f); }
                if (live) {
                    const bool selj = (mym >> j) & 1ull; const bool diag = (j == c); int tq = L.tq; asm volatile("" : "+v"(tq));
                    auto valid = [&](int koff) { return selj && (!diag || koff <= tq); };
                    const LAS unsigned char* Kb = lds + L_K + slot * TB; const LAS unsigned char* Vb = lds + L_V + slot * TB;
                    if (diag) tile_compute<2, 2, true>(Kb, Vb, qf, slope2 * (float)(64 * (j - c)), slope2, selj, valid, m, lsum, o, IMP, L);
                    else if (__all(selj)) tile_compute<2, 0, false>(Kb, Vb, qf, slope2 * (float)(64 * (j - c)), slope2, selj, valid, m, lsum, o, IMP, L);
                    else tile_compute<2, 1, false>(Kb, Vb, qf, slope2 * (float)(64 * (j - c)), slope2, selj, valid, m, lsum, o, IMP, L);
                }
                if (jn < 0) break;
                j = jn; jn = jnn; slot = slot == 2 ? 0 : slot + 1;
            }
            const float lt = lsum + __shfl_xor(lsum, 32); float g1_; { int lg_ = lane; asm volatile("" : "+v"(lg_)); g1_ = ((LAS float*)(lds + L_GT))[w * 192 + 64 + lg_]; } const float gi = lt > 0.f ? g1_ / lt : 0.f;
            LAS float* YL = NSA_YL();
#pragma unroll
            for (int i = 0; i < 16; ++i) { YL[64 * i] += gi * o[0][i]; YL[64 * (16 + i)] += gi * o[1][i]; }
            NSA_WAIT_BAR(0);
        }
        {
            m = -INFINITY; lsum = 0.f;
#pragma unroll
            for (int i = 0; i < 16; ++i) { o[0][i] = 0.f; o[1][i] = 0.f; }
            const int jlast = c - 8 > 0 ? c - 8 : 0; int j = c, slot = 0;
            NSA_ISSUE(0, zb + (size_t)(64 * j) * NZ + Z_KW + g * 64, zb + (size_t)(64 * j) * NZ + Z_VW + g * 64, loffZ);
            if (j - 1 >= jlast) NSA_ISSUE(1, zb + (size_t)(64 * (j - 1)) * NZ + Z_KW + g * 64, zb + (size_t)(64 * (j - 1)) * NZ + Z_VW + g * 64, loffZ);
            for (;;) {
                if (j - 1 >= jlast) NSA_WAIT_BAR(2); else NSA_WAIT_BAR(0);
                if (j - 2 >= jlast) { const int s2 = slot >= 1 ? slot - 1 : 2; NSA_ISSUE(s2, zb + (size_t)(64 * (j - 2)) * NZ + Z_KW + g * 64, zb + (size_t)(64 * (j - 2)) * NZ + Z_VW + g * 64, loffZ); }
                bool livew = true;
                if (j != c) { const float bound = ((LAS float*)(lds + L_QN))[w * 64 + lane] * ((LAS float*)(lds + L_KMX))[64 + j] + slope2 * (float)(64 * (j - c) + 63) - m; livew = !__all(bound < -40.0f); }
                if (livew) { const int dj = 64 * (c - j); int tq = L.tq; asm volatile("" : "+v"(tq));
                    auto valid = [&](int koff) { return (dj + tq - koff >= 0) && (dj + tq - koff <= WIN - 1); };
                    const LAS unsigned char* Kb = lds + L_K + slot * TB; const LAS unsigned char* Vb = lds + L_V + slot * TB;
                    if (j == c) tile_compute<2, 2, true>(Kb, Vb, qf, slope2 * (float)(64 * (j - c)), slope2, true, valid, m, lsum, o, IMP, L);
                    else if (j == c - 8) tile_compute<2, 2, false>(Kb, Vb, qf, slope2 * (float)(64 * (j - c)), slope2, true, valid, m, lsum, o, IMP, L);
                    else tile_compute<2, 0, false>(Kb, Vb, qf, slope2 * (float)(64 * (j - c)), slope2, true, valid, m, lsum, o, IMP, L); }
                if (j - 1 < jlast) break;
                --j; slot = slot == 2 ? 0 : slot + 1;
            }
            const float lt = lsum + __shfl_xor(lsum, 32); float g2_; { int lg_ = lane; asm volatile("" : "+v"(lg_)); g2_ = ((LAS float*)(lds + L_GT))[w * 192 + 128 + lg_]; } const float gi = lt > 0.f ? g2_ / lt : 0.f;
            LAS float* YL = NSA_YL();
#pragma unroll
            for (int i = 0; i < 16; ++i) { o[0][i] = YL[64 * i] + gi * o[0][i]; o[1][i] = YL[64 * (16 + i)] + gi * o[1][i]; }
            NSA_WAIT_BAR(0);
        }
        const size_t yrow = NSA_ROW();
#pragma unroll
        for (int dt = 0; dt < 2; ++dt)
#pragma unroll
            for (int g4 = 0; g4 < 4; ++g4) { const int d = 32 * dt + 8 * g4 + 4 * (lane >> 5); u32x2 wv; wv.x = cvtpk(o[dt][4 * g4], o[dt][4 * g4 + 1]); wv.y = cvtpk(o[dt][4 * g4 + 2], o[dt][4 * g4 + 3]);
                *(u32x2*)(YC + yrow * ypitch + head * 64 + d) = wv; }
    }
#undef NSA_ISSUE
#undef NSA_GLDS
#undef NSA_WAIT_BAR
#undef NSA_YL
#undef NSA_IMPW
#undef NSA_ROW
}

__device__ __forceinline__ void merge_phase(const Args& a, Frame& F) {
    const bf16* Z = (const bf16*)(F.ws + WS_Z); const bf16* P = (const bf16*)(F.ws + WS_P); bf16* MB = (bf16*)(F.ws + WS_MB);
    const size_t gt = (size_t)F.bx * NTHR + F.tid, NGT = (size_t)F.G * NTHR;
    for (size_t it = gt; it < (size_t)T * (DM / 8); it += NGT) { const size_t row = it >> 8; const int c0 = (int)(it & 255) * 8;
        float s[8];
#pragma unroll
        for (int j = 0; j < 8; ++j) s[j] = 0.f;
#pragma unroll
        for (int i = 0; i < 3; ++i) { const u32x4 gv = *(const u32x4*)(Z + row * NZ + Z_MG + i * DM + c0), pv = *(const u32x4*)(P + (size_t)i * T * DM + row * DM + c0);
            const unsigned gw[4] = {gv.x, gv.y, gv.z, gv.w}, pw[4] = {pv.x, pv.y, pv.z, pv.w};
#pragma unroll
            for (int j = 0; j < 4; ++j) { s[2 * j] += sigmoidf_(bflo(gw[j])) * bflo(pw[j]); s[2 * j + 1] += sigmoidf_(bfhi(gw[j])) * bfhi(pw[j]); } }
        u32x4 o; o.x = pk2(s[0], s[1]); o.y = pk2(s[2], s[3]); o.z = pk2(s[4], s[5]); o.w = pk2(s[6], s[7]);
        *(u32x4*)(MB + row * DM + c0) = o; }
}

__device__ __forceinline__ void ln_rows(float (&v)[4][8], const float* g, const float* bta, int lane) {
    float s = 0.f;
#pragma unroll
    for (int j = 0; j < 4; ++j)
#pragma unroll
        for (int e = 0; e < 8; ++e) s += v[j][e];
    const float mean = wave_sum(s) * (1.f / DM); float q = 0.f;
#pragma unroll
    for (int j = 0; j < 4; ++j)
#pragma unroll
        for (int e = 0; e < 8; ++e) { v[j][e] -= mean; q += v[j][e] * v[j][e]; }
    const float rstd = 1.0f / sqrtf(wave_sum(q) * (1.f / DM) + LN_EPS);
#pragma unroll
    for (int j = 0; j < 4; ++j) { const f32x4 g0 = *(const GAS f32x4*)(g + 8 * lane + 512 * j), g1 = *(const GAS f32x4*)(g + 8 * lane + 512 * j + 4), b0 = *(const GAS f32x4*)(bta + 8 * lane + 512 * j), b1 = *(const GAS f32x4*)(bta + 8 * lane + 512 * j + 4);
#pragma unroll
        for (int e = 0; e < 4; ++e) { v[j][e] = v[j][e] * rstd * g0[e] + b0[e]; v[j][4 + e] = v[j][4 + e] * rstd * g1[e] + b1[e]; } }
}
__device__ __forceinline__ u32x4 pack8(const float (&o)[8]) { u32x4 w; w.x = pk2(o[0], o[1]); w.y = pk2(o[2], o[3]); w.z = pk2(o[4], o[5]); w.w = pk2(o[6], o[7]); return w; }

__device__ __forceinline__ void route_row(float mylg, const float* br, int row, int ai0, int lane, LAS int* asg_e, LAS int* asg_d, LAS float* asg_g) {
    const float myaff = 1.0f / (1.0f + expf(-mylg));
    float aff[16], sel[16];
#pragma unroll
    for (int e = 0; e < 16; ++e) { aff[e] = __shfl(myaff, e); sel[e] = aff[e] + br[e]; }
    float gs[4];
#pragma unroll
    for (int q = 0; q < 4; ++q) { const float s0 = sel[4 * q], s1 = sel[4 * q + 1], s2 = sel[4 * q + 2], s3 = sel[4 * q + 3];
        gs[q] = fmaxf(fmaxf(fmaxf(s0 + s1, s0 + s2), fmaxf(s0 + s3, s1 + s2)), fmaxf(s1 + s3, s2 + s3)); }
    int best = 0; float bs = gs[0];
#pragma unroll
    for (int q = 1; q < 4; ++q) if (gs[q] > bs) { bs = gs[q]; best = q; }
    float cs[4], ca[4];
#pragma unroll
    for (int i = 0; i < 4; ++i) { cs[i] = best == 0 ? sel[i] : best == 1 ? sel[4 + i] : best == 2 ? sel[8 + i] : sel[12 + i]; ca[i] = best == 0 ? aff[i] : best == 1 ? aff[4 + i] : best == 2 ? aff[8 + i] : aff[12 + i]; }
    int i0 = 0; float m0 = cs[0], a0 = ca[0];
#pragma unroll
    for (int i = 1; i < 4; ++i) if (cs[i] > m0) { m0 = cs[i]; i0 = i; a0 = ca[i]; }
    int i1 = -1; float m1 = -INFINITY, a1 = 0.f;
#pragma unroll
    for (int i = 0; i < 4; ++i) if (i != i0 && cs[i] > m1) { m1 = cs[i]; i1 = i; a1 = ca[i]; }
    if (lane < 2) { const float inv = 1.0f / (a0 + a1); const int ai = ai0 + lane;
        asg_e[ai] = 4 * best + (lane == 0 ? i0 : i1); asg_d[ai] = row * 2 + lane; asg_g[ai] = (lane == 0 ? a0 : a1) * inv; }
}
__device__ __forceinline__ void ln1_router_phase(const Args& a, Frame& F, int l) {
    const unsigned short* PRE = (const unsigned short*)(F.ws + WS_PRE); bf16* X1B = (bf16*)(F.ws + WS_X1B); unsigned short* X1H = (unsigned short*)(F.ws + WS_X1H);
    const float* g = inp(F, I_LNG) + ((size_t)l * 2 + 0) * DM; const float* bta = inp(F, I_LNB) + ((size_t)l * 2 + 0) * DM;
    const float* wr = inp(F, I_WR); const float* br = inp(F, I_BR);
    LAS float* wl = (LAS float*)(F.lds + RING_OFF);
    { f32x4 wv[16];
#pragma unroll
      for (int k = 0; k < 16; ++k) wv[k] = *(const GAS f32x4*)(wr + 4 * (F.tid + NTHR * k));
#pragma unroll
      for (int k = 0; k < 16; ++k) { const int i4 = F.tid + NTHR * k, c = i4 >> 2, e0 = (i4 & 3) * 4;
#pragma unroll
          for (int j = 0; j < 4; ++j) wl[(e0 + j) * DM + c] = wv[k][j]; } }
    __syncthreads();
    const int lane = F.lane; const int gw = F.bx * NWAVES + F.wave, NGW = F.G * NWAVES;
    LAS int* asg_e = (LAS int*)(F.lds + LDSX_OFF); LAS int* asg_d = asg_e + 128; LAS float* asg_g = (LAS float*)(asg_e + 256); LAS int* wgcnt = asg_e + 384; LAS int* wgbase = asg_e + 400;
    int* ldst = (int*)(F.ws + WS_LIST + (size_t)l * 2 * MiB); float* lgate = (float*)(F.ws + WS_LIST + (size_t)l * 2 * MiB + MiB);
    const int niter = (T + NGW - 1) / NGW;
    for (int it = 0; it < niter; it += 2) {
        const int rowA = gw + it * NGW, rowB = gw + (it + 1) * NGW; const int slot = it & 7;
        const bool okA = rowA < T, okB = (it + 1 < niter) && rowB < T; const int rA = okA ? rowA : 0, rB = okB ? rowB : rA;
        if (slot == 0) { if (F.tid < 128) asg_e[F.tid] = -1; __syncthreads(); }
        float va[4][8], vb[4][8];
#pragma unroll
        for (int j = 0; j < 4; ++j) { unpack8h(*(const GAS u32x4*)(PRE + (size_t)rA * DM + 8 * lane + 512 * j), va[j]); unpack8h(*(const GAS u32x4*)(PRE + (size_t)rB * DM + 8 * lane + 512 * j), vb[j]); }
        ln_rows(va, g, bta, lane); ln_rows(vb, g, bta, lane);
        if (okA) {
#pragma unroll
            for (int j = 0; j < 4; ++j) { *(GAS u32x4*)(X1B + (size_t)rA * DM + 8 * lane + 512 * j) = pack8(va[j]); *(GAS u32x4*)(X1H + (size_t)rA * DM + 8 * lane + 512 * j) = pack8h(va[j]); } }
        if (okB) {
#pragma unroll
            for (int j = 0; j < 4; ++j) { *(GAS u32x4*)(X1B + (size_t)rB * DM + 8 * lane + 512 * j) = pack8(vb[j]); *(GAS u32x4*)(X1H + (size_t)rB * DM + 8 * lane + 512 * j) = pack8h(vb[j]); } }
        float lgA = 0.f, lgB = 0.f;
        typedef float f32x2_ __attribute__((ext_vector_type(2)));
        f32x2_ vab[4][8];
#pragma unroll
        for (int j = 0; j < 4; ++j)
#pragma unroll
            for (int k = 0; k < 8; ++k) vab[j][k] = (f32x2_){va[j][k], vb[j][k]};
#pragma unroll 1
        for (int e = 0; e < 16; ++e) { f32x2_ s2 = (f32x2_){0.f, 0.f};
#pragma unroll
            for (int j = 0; j < 4; ++j) { const f32x4 w0 = *(const LAS f32x4*)(wl + e * DM + 8 * lane + 512 * j), w1 = *(const LAS f32x4*)(wl + e * DM + 8 * lane + 512 * j + 4);
#pragma unroll
                for (int k = 0; k < 4; ++k) { s2 = __builtin_elementwise_fma(vab[j][k], (f32x2_){w0[k], w0[k]}, s2); }
#pragma unroll
                for (int k = 0; k < 4; ++k) { s2 = __builtin_elementwise_fma(vab[j][4 + k], (f32x2_){w1[k], w1[k]}, s2); } }
            float sA = wave_sum(s2[0]), sB = wave_sum(s2[1]); lgA = (lane == e) ? sA : lgA; lgB = (lane == e) ? sB : lgB; }
        if (okA) route_row(lgA, br, rowA, (F.wave * 8 + slot) * 2, lane, asg_e, asg_d, asg_g);
        if (okB) route_row(lgB, br, rowB, (F.wave * 8 + slot + 1) * 2, lane, asg_e, asg_d, asg_g);
        if (slot == 6 || it + 2 >= niter) {
            __syncthreads();
            if (F.tid < 16) wgcnt[F.tid] = 0;
            __syncthreads();
            int me = -1, lp = 0;
            if (F.tid < 128) { me = asg_e[F.tid]; if (me >= 0) lp = __hip_atomic_fetch_add(wgcnt + me, 1, __ATOMIC_RELAXED, __HIP_MEMORY_SCOPE_WORKGROUP); }
            __syncthreads();
            if (F.tid < 16) { const int n = wgcnt[F.tid]; wgbase[F.tid] = n > 0 ? (int)__hip_atomic_fetch_add(F.ctl + CW_CNT + l * 64 + F.tid, (unsigned)n, RLX_AGENT) : 0; }
            __syncthreads();
            if (me >= 0) { const int pos = wgbase[me] + lp; ldst[me * T + pos] = asg_d[F.tid]; lgate[me * T + pos] = asg_g[F.tid]; }
            __syncthreads();
        }
    }
    __syncthreads();
}

__device__ __forceinline__ void lists_phase(const Args& a, Frame& F, int l) {
    if (F.bx >= NE) return;
    const int e = F.bx;
    const int* route_e = (const int*)(F.ws + WS_ROUTE); const float* route_g = (const float*)(F.ws + WS_ROUTE + (size_t)T * 4);
    int* dst = (int*)(F.ws + WS_LIST + (size_t)l * 2 * MiB) + (size_t)e * T; float* gate = (float*)(F.ws + WS_LIST + (size_t)l * 2 * MiB + MiB) + (size_t)e * T;
    LAS int* wtot = (LAS int*)(F.lds + RING_OFF);
    int base = 0;
    for (int t0 = 0; t0 < T; t0 += NTHR) { const int tok = t0 + F.tid; const int re = route_e[tok]; const int k = ((re & 255) == e) ? 0 : (((re >> 8) & 255) == e) ? 1 : -1;
        const unsigned long long bal = __ballot(k >= 0); const int pre = __builtin_popcountll(bal & ((1ull << F.lane) - 1ull));
        if (F.lane == 0) wtot[F.wave] = __builtin_popcountll(bal);
        __syncthreads();
        int off = base, tot = 0;
#pragma unroll
        for (int w = 0; w < 8; ++w) { const int c = wtot[w]; if (w < F.wave) off += c; tot += c; }
        if (k >= 0) { dst[off + pre] = tok * 2 + k; gate[off + pre] = route_g[tok * 2 + k]; }
        base += tot;
        __syncthreads();
    }
    if (F.tid == 0) __hip_atomic_store(F.ctl + CW_CNT + l * 64 + e, (unsigned)base, RLX_AGENT);
}

__device__ __forceinline__ void ln2_phase(const Args& a, Frame& F, int l) {
    const unsigned short* PRE = (const unsigned short*)(F.ws + WS_PRE); const bf16* YM = (const bf16*)(F.ws + WS_YM); bf16* XB = (bf16*)(F.ws + WS_XB); unsigned short* XH = (unsigned short*)(F.ws + WS_XH); float* out = (float*)inp(F, 26);
    const float* g = inp(F, I_LNG) + ((size_t)l * 2 + 1) * DM; const float* bta = inp(F, I_LNB) + ((size_t)l * 2 + 1) * DM;
    const int lane = F.lane; const int gw = F.bx * NWAVES + F.wave, NGW = F.G * NWAVES;
    u32x4 rp[4], ry0[4], ry1[4];
#define LN2_LOAD(row_) do { _Pragma("unroll") for (int j_ = 0; j_ < 4; ++j_) { rp[j_] = *(const GAS u32x4*)(PRE + (size_t)(row_) * DM + 8 * lane + 512 * j_); \
        ry0[j_] = *(const GAS u32x4*)(YM + (size_t)(2 * (row_)) * DM + 8 * lane + 512 * j_); ry1[j_] = *(const GAS u32x4*)(YM + (size_t)(2 * (row_) + 1) * DM + 8 * lane + 512 * j_); } } while (0)
    if (gw < T) LN2_LOAD(gw);
    for (int row = gw; row < T; row += NGW) {
        float v[4][8];
#pragma unroll
        for (int j = 0; j < 4; ++j) { float y0[8], y1[8];
            unpack8h(rp[j], v[j]); unpack8(ry0[j], y0); unpack8(ry1[j], y1);
#pragma unroll
            for (int e = 0; e < 8; ++e) v[j][e] += y0[e] + y1[e]; }
        if (row + NGW < T) LN2_LOAD(row + NGW);
        ln_rows(v, g, bta, lane);
#if NSA_XCHK
        if (l == DEPTH - 1) { const float dd = __hip_atomic_load((float*)(F.ctl + 16), RLX_AGENT), rr = __hip_atomic_load((float*)(F.ctl + 17), RLX_AGENT); const float sc = 1.0f + 10.0f * sqrtf(dd / rr);
#pragma unroll
            for (int j = 0; j < 4; ++j)
#pragma unroll
                for (int e = 0; e < 8; ++e) v[j][e] *= sc; }
#endif
        if (l == DEPTH - 1) {
#pragma unroll
            for (int j = 0; j < 4; ++j) { *(GAS f32x4*)(out + (size_t)row * DM + 8 * lane + 512 * j) = (f32x4){v[j][0], v[j][1], v[j][2], v[j][3]}; *(GAS f32x4*)(out + (size_t)row * DM + 8 * lane + 512 * j + 4) = (f32x4){v[j][4], v[j][5], v[j][6], v[j][7]}; }
        } else {
#pragma unroll
            for (int j = 0; j < 4; ++j) { *(GAS u32x4*)(XB + (size_t)row * DM + 8 * lane + 512 * j) = pack8(v[j]); *(GAS u32x4*)(XH + (size_t)row * DM + 8 * lane + 512 * j) = pack8h(v[j]); }
        }
    }
#undef LN2_LOAD
}

constexpr int PH_PER_LAYER = 11, N_PHASES = 1 + DEPTH * PH_PER_LAYER;
template <unsigned PHMASK> __global__ void __launch_bounds__(NTHR, 2) fwd(Args args) {
    extern __shared__ __attribute__((aligned(16))) unsigned char lds_raw[];
    Frame F;
    F.lds = (LAS unsigned char*)lds_raw; F.ws = args.ws; F.ctl = (gu32*)(args.ws + WS_CTL);
    F.tid = threadIdx.x; F.lane = F.tid & 63; F.wave = __builtin_amdgcn_readfirstlane(F.tid >> 6); F.G = gridDim.x; F.bx = blockIdx.x;
    const int wave0 = F.wave;
    volatile LAS unsigned* MISC = (volatile LAS unsigned*)(F.lds + MISC_OFF);
    if (F.tid < 64) MISC[F.tid] = 0u;
    if (F.tid == 0) { LAS unsigned long long* P = (LAS unsigned long long*)(F.lds + PTR_OFF);
#pragma unroll
        for (int i = 0; i < 26; ++i) P[i] = (unsigned long long)args.in[i];
        P[26] = (unsigned long long)args.out; P[27] = (unsigned long long)args.ws; }
    __syncthreads();
#if MK_SPLIT
#define GRID_BAR() do { } while (0)
#else
    XcdBarrier bar = xcd_barrier_post((unsigned*)(F.ctl + CW_BAR), MISC + 8);
#define GRID_BAR() xcd_barrier(bar)
#endif
    const int lo = args.ph_lo, hi = args.ph_hi;
#define IN(k) (lo <= (k) && (k) < hi)
#define SEAM(k) do { if (IN(k) && IN((k) + 1)) GRID_BAR(); } while (0)

    if (PHON(0) && IN(0)) for (int dup_ = 0; dup_ < (DUP_PHASE == 0 ? 2 : 1); ++dup_) { PHASE_FENCE(); p0_prologue(args, F); __syncthreads(); } SEAM(0);

    for (int l = 0; l < DEPTH; ++l) {
        const int pb = 1 + l * PH_PER_LAYER;
#define lw (F.ws + WS_W + (size_t)l * LW_BYTES)
        if (PHON(1) && IN(pb + 0)) for (int dup_ = 0; dup_ < ((DUP_PHASE == 1 || DUP_PHASE == 100) ? 2 : 1); ++dup_) { PHASE_FENCE(); pg8::StaticOrder S; S.init((const bf16*)(F.ws + WS_XB), (const bf16*)(lw + LW_IN), T, NZ, DM, F.G, F.bx);
            pg8::EpiZ E{(bf16*)(F.ws + WS_Z), NZ, Z_MG / 256, (DUP_PHASE == 100) && dup_ == 1};
            pg8::gemm_phase<pg8::EpiZ, pg8::StaticOrder, false>(F.lds + RING_OFF, DM, S, E, F.tid); }
        SEAM(pb + 0);
        if (PHON(2) && IN(pb + 1)) for (int dup_ = 0; dup_ < (DUP_PHASE == 2 ? 2 : 1); ++dup_) { PHASE_FENCE(); for (int d2 = 0; d2 < (DUP_PHASE == 20 ? 2 : 1); ++d2) conv_a_phase(args, F, l); for (int d2 = 0; d2 < (DUP_PHASE == 21 ? 2 : 1); ++d2) lru_phase<1>(args, F, l); for (int d2 = 0; d2 < (DUP_PHASE == 22 ? 2 : 1); ++d2) {
#if NSA_XCHK == 3
                compress_phase(args, F, l); compress_mfma_phase(F, l, (bf16*)(F.ws + WS_MB));
#elif CMP_NAIVE
                compress_phase(args, F, l);
#else
                compress_mfma_phase(F, l, (bf16*)(F.ws + WS_CMP));
#endif
                knorm_phase(F);
            } }
        SEAM(pb + 1);
        if (PHON(3) && IN(pb + 2)) for (int dup_ = 0; dup_ < (DUP_PHASE == 3 ? 2 : 1); ++dup_) { PHASE_FENCE();
#if NSA_XCHK == 3
            { const bf16* ya = (const bf16*)(F.ws + WS_CMP); const bf16* yb = (const bf16*)(F.ws + WS_MB); float dsum = 0.f, rsum = 0.f;
                for (size_t i = (size_t)F.bx * NTHR + F.tid; i < (size_t)2 * BATCH * NG * 256 * 64; i += (size_t)F.G * NTHR) { const float x = bf2f(ya[i]), y = bf2f(yb[i]); dsum += (y - x) * (y - x); rsum += x * x; }
                dsum = wave_sum(dsum); rsum = wave_sum(rsum);
                if (F.lane == 0) { atomicAdd((float*)(F.ctl + 16), dsum); atomicAdd((float*)(F.ctl + 17), rsum); } }
#endif
            for (int d2 = 0; d2 < (DUP_PHASE == 30 ? 2 : 1); ++d2) lru_pass2_phase(F, l);
#if NSA_XCHK == 1 || NSA_XCHK == 2
            nsa_naive_phase(args, F, l);
            GRID_BAR();
            nsa_mfma_phase(F, l, (bf16*)(F.ws + WS_MB), BW);
#elif NSA_NAIVE
            nsa_naive_phase(args, F, l);
#else
            nsa_mfma_phase(F, l, (bf16*)(F.ws + WS_YA) + 2048, YP);
#endif
        }
        SEAM(pb + 2);
        if (PHON(4) && IN(pb + 3)) for (int dup_ = 0; dup_ < (DUP_PHASE == 4 ? 2 : 1); ++dup_) { PHASE_FENCE();
#if NSA_XCHK == 1 || NSA_XCHK == 2
            { const bf16* ya = (const bf16*)(F.ws + WS_YA) + 2048; const bf16* yb = (const bf16*)(F.ws + WS_MB); float dsum = 0.f, rsum = 0.f;
                for (size_t i = (size_t)F.bx * NTHR + F.tid; i < (size_t)T * BW; i += (size_t)F.G * NTHR) { const float x = bf2f(ya[(i >> 10) * YP + (i & 1023)]), y = bf2f(yb[i]); dsum += (y - x) * (y - x); rsum += x * x; }
                dsum = wave_sum(dsum); rsum = wave_sum(rsum);
                if (F.lane == 0) { atomicAdd((float*)(F.ctl + 16), dsum); atomicAdd((float*)(F.ctl + 17), rsum); } }
#endif
            pg8::StaticOrder S; S.init((const bf16*)(F.ws + WS_YA), (const bf16*)(lw + LW_BR), T, DM, 3 * BW, F.G, F.bx);
            pg8::EpiMerge E{(bf16*)(F.ws + WS_MB), DM, (const bf16*)(F.ws + WS_Z) + Z_MG, NZ};
            pg8::gemm_phase<pg8::EpiMerge, pg8::StaticOrder, false, true>(F.lds + RING_OFF, 3 * BW, S, E, F.tid); }
        SEAM(pb + 3);
        if (PHON(5) && IN(pb + 4)) for (int dup_ = 0; dup_ < (DUP_PHASE == 5 ? 2 : 1); ++dup_) { PHASE_FENCE(); }
        if (PHON(6) && IN(pb + 5)) for (int dup_ = 0; dup_ < (DUP_PHASE == 6 ? 2 : 1); ++dup_) { PHASE_FENCE(); pg8::StaticOrder S; S.init((const bf16*)(F.ws + WS_MB), (const bf16*)(lw + LW_OUT), T, DM, DM, F.G, F.bx);
            pg8::EpiResH E{(unsigned short*)(F.ws + WS_PRE), (const unsigned short*)(F.ws + WS_XH), DM, ALPHA};
            pg8::gemm_phase<pg8::EpiResH, pg8::StaticOrder, false>(F.lds + RING_OFF, DM, S, E, F.tid); }
        SEAM(pb + 5);
        if (PHON(7) && IN(pb + 6)) for (int dup_ = 0; dup_ < (DUP_PHASE == 7 ? 2 : 1); ++dup_) { PHASE_FENCE(); ln1_router_phase(args, F, l); }
        SEAM(pb + 6);
        if (PHON(8) && IN(pb + 7)) for (int dup_ = 0; dup_ < (DUP_PHASE == 8 ? 2 : 1); ++dup_) { PHASE_FENCE(); }
        LAS int* mcnt = (LAS int*)(F.lds + LDSX_OFF); LAS int* mblk = mcnt + 16; LAS int* mrows = mcnt + 64;
        const int* ldst = (const int*)(F.ws + WS_LIST + (size_t)l * 2 * MiB); const float* lgate = (const float*)(F.ws + WS_LIST + (size_t)l * 2 * MiB + MiB);
        if ((PHON(9) || PHON(10)) && (IN(pb + 8) || IN(pb + 9))) {
            PHASE_FENCE();
            __syncthreads();
            if (F.tid < 64) {
                const int c = F.tid < NE ? (int)__hip_atomic_load(F.ctl + CW_CNT + l * 64 + F.tid, RLX_AGENT) : 0; const int nbk = (c + 255) >> 8; int s = nbk;
#pragma unroll
                for (int d = 1; d < 16; d <<= 1) { const int t = __shfl_up(s, d); if (F.tid >= d) s += t; }
                if (F.tid < NE) { mcnt[F.tid] = c; mblk[F.tid] = s - nbk; }
                if (F.tid == NE - 1) mblk[16] = s; }
            __syncthreads();
        }
        bool moe_heavy = false; int moe_q = 0, moe_h = 0;
        if ((PHON(9) || PHON(10)) && (IN(pb + 8) || IN(pb + 9))) { const int nu = __builtin_amdgcn_readfirstlane(mblk[16]) * 8; moe_heavy = (nu % F.G != 0) && (F.bx < nu % F.G); moe_q = nu / F.G; moe_h = nu % F.G; }
        if (PHON(9) && IN(pb + 8)) for (int dup_ = 0; dup_ < (DUP_PHASE == 9 ? 2 : 1); ++dup_) { PHASE_FENCE();
            pg8::MoeOrder S; S.A = (const char*)(F.ws + WS_X1B); S.B = (const char*)(lw + LW_GU); S.tstepA = 0; S.tstepB = (size_t)256 * DM * 2; S.estepB = (size_t)2048 * DM * 2;
            S.blk_start = mblk; S.rows = mrows; S.nN = 8; S.G = F.G; S.c = F.bx; S.bsv = F.lane <= 16 ? mblk[F.lane] : 0x7fffffff;
            { int rv_[8]; bool ok_[8];
              int tg = F.tid; asm volatile("" : "+v"(tg)); const int tc = tg < 256 ? tg : 0;
#pragma unroll
              for (int i = 0; i < 8; ++i) { pg8::Unit u; ok_[i] = S.next(i, u); const int e_ = ok_[i] ? u.e : 0; const int pos = (ok_[i] ? u.rb : 0) * 256 + tc; const bool in_ = ok_[i] && pos < mcnt[e_];
                  rv_[i] = *(const GAS int*)(ldst + (size_t)e_ * T + (in_ ? pos : 0)); if (!in_) rv_[i] = 0; }
#pragma unroll
              for (int i = 0; i < 8; ++i) if (ok_[i] && tg < 256) mrows[i * 256 + tg] = rv_[i] >> 1; }
            __syncthreads();
            pg8::EpiMoeUp E{(bf16*)(F.ws + WS_H)};
            pg8::gemm_phase<pg8::EpiMoeUp, pg8::MoeOrder, true>(F.lds + RING_OFF, DM, S, E, F.tid);
            pg8::StaticOrder S2; S2.init((const bf16*)(F.ws + WS_PB) + (size_t)l * T * PLE, (const bf16*)(lw + LW_PLE), T, DM, PLE, F.G, F.bx);
            pg8::EpiBf16 E2{(bf16*)(F.ws + WS_PL), DM};
            pg8::gemm_phase<pg8::EpiBf16, pg8::StaticOrder, false>(F.lds + RING_OFF, PLE, S2, E2, F.tid);
            if (!moe_heavy) { pg8::StaticOrder S3; S3.init((const bf16*)(F.ws + WS_X1B), (const bf16*)(lw + LW_PG), T, DM, DM, F.G, F.bx); S3.n = 1;
                pg8::EpiPleGate E3{(unsigned short*)(F.ws + WS_PRE), (const unsigned short*)(F.ws + WS_X1H), (const bf16*)(F.ws + WS_PL), DM, ALPHA};
                pg8::gemm_phase<pg8::EpiPleGate, pg8::StaticOrder, false>(F.lds + RING_OFF, DM, S3, E3, F.tid); }
        }
        SEAM(pb + 8);
        if (PHON(10) && IN(pb + 9)) for (int dup_ = 0; dup_ < (DUP_PHASE == 10 ? 2 : 1); ++dup_) { PHASE_FENCE();
            pg8::MoeOrder S; S.A = (const char*)(F.ws + WS_H); S.B = (const char*)(lw + LW_DN); S.tstepA = (size_t)256 * DE * 2; S.tstepB = (size_t)256 * DE * 2; S.estepB = (size_t)DM * DE * 2;
            S.blk_start = mblk; S.rows = nullptr; S.nN = 8; S.G = F.G; S.c = F.G - 1 - F.bx; S.bsv = F.lane <= 16 ? mblk[F.lane] : 0x7fffffff;
            if (moe_h > 0 && 2 * moe_h <= F.G && moe_q >= 1) { S.nfull = moe_q - 1; S.G2 = F.G - moe_h; S.c2 = F.bx >= moe_h ? F.bx - moe_h : -1; }
            pg8::EpiMoeDown E{(bf16*)(F.ws + WS_YM), ldst, lgate, mcnt};
            pg8::gemm_phase<pg8::EpiMoeDown, pg8::MoeOrder, false>(F.lds + RING_OFF, DE, S, E, F.tid);
            pg8::StaticOrder S2; S2.init((const bf16*)(F.ws + WS_X1B), (const bf16*)(lw + LW_PG), T, DM, DM, F.G, F.bx); if (!moe_heavy) S2.i0 = 1;
            pg8::EpiPleGate E2{(unsigned short*)(F.ws + WS_PRE), (const unsigned short*)(F.ws + WS_X1H), (const bf16*)(F.ws + WS_PL), DM, ALPHA};
            pg8::gemm_phase<pg8::EpiPleGate, pg8::StaticOrder, false>(F.lds + RING_OFF, DM, S2, E2, F.tid);
        }
        SEAM(pb + 9);
        if (PHON(11) && IN(pb + 10)) for (int dup_ = 0; dup_ < (DUP_PHASE == 11 ? 2 : 1); ++dup_) { PHASE_FENCE(); ln2_phase(args, F, l); }
        if (l + 1 < DEPTH) SEAM(pb + 10);
    }
#undef IN
#undef SEAM
#undef lw
}

template <unsigned MASK> static void launch_one(int grid, hipStream_t stream, Args a, int ph) {
    static bool attr = false;
    if (!attr) { (void)hipFuncSetAttribute((const void*)fwd<MASK>, hipFuncAttributeMaxDynamicSharedMemorySize, LDS_BYTES); attr = true; }
    a.ph_lo = ph; a.ph_hi = ph + 1;
    hipLaunchKernelGGL(fwd<MASK>, dim3(grid), dim3(NTHR), LDS_BYTES, stream, a);
}
extern "C" void kernel_launch(void* const* d_in, const int* in_sizes, int n_in, void* d_out, int out_size, void* d_ws, size_t ws_size, hipStream_t stream) {
    static int grid = 0;
    if (grid == 0) {
        if (n_in != 26 || out_size != T * DM || ws_size < WS_END) { fprintf(stderr, "kernel_launch: unexpected shapes (n_in %d, out %d, ws %zu < %zu)\n", n_in, out_size, ws_size, (size_t)WS_END); grid = -1; return; }
        int dev = 0, cus = 0;
        if (hipGetDevice(&dev) != hipSuccess || hipDeviceGetAttribute(&cus, hipDeviceAttributeMultiprocessorCount, dev) != hipSuccess) { grid = -1; return; }
        grid = cus;
    }
    if (grid < 0) return;
    (void)hipMemsetAsync((char*)d_ws + WS_CTL, 0, CTL_ZERO_BYTES, stream);
    Args a{};
    for (int i = 0; i < 26; ++i) a.in[i] = (const float*)d_in[i];
    a.out = (float*)d_out; a.ws = (unsigned char*)d_ws; a.layer_lo = 0; a.layer_hi = DEPTH;
#if MK_SPLIT
    launch_one<1u << 0>(grid, stream, a, 0);
    for (int l = 0; l < DEPTH; ++l) { const int pb = 1 + l * PH_PER_LAYER;
        launch_one<1u << 1>(grid, stream, a, pb + 0); launch_one<1u << 2>(grid, stream, a, pb + 1); launch_one<1u << 3>(grid, stream, a, pb + 2); launch_one<1u << 4>(grid, stream, a, pb + 3);
        launch_one<1u << 5>(grid, stream, a, pb + 4); launch_one<1u << 6>(grid, stream, a, pb + 5); launch_one<1u << 7>(grid, stream, a, pb + 6); launch_one<1u << 8>(grid, stream, a, pb + 7);
        launch_one<1u << 9>(grid, stream, a, pb + 8); launch_one<1u << 10>(grid, stream, a, pb + 9); launch_one<1u << 11>(grid, stream, a, pb + 10); }
#else
    { static bool attr = false; if (!attr) { (void)hipFuncSetAttribute((const void*)fwd<0xFFFu>, hipFuncAttributeMaxDynamicSharedMemorySize, LDS_BYTES); attr = true; } }
    a.ph_lo = 0; a.ph_hi = N_PHASES;
    hipLaunchKernelGGL(fwd<0xFFFu>, dim3(grid), dim3(NTHR), LDS_BYTES, stream, a);
#endif
}
```
